# Optimizing an MI355X kernel written in HIP

```python
import jax, jax.numpy as jnp
from jax import lax
import numpy as np

D_MODEL = 1024
BATCH = 2
SEQ = 8192
DEPTH = 1
DEC_BATCH = 128
DEC_SEQ = 8
PAST_LEN = 16384
PAGE_SIZE = 128

HEAD_DIM = 64
ATT_HEADS = 8
KV_HEADS = 2
Q_PER_KV = ATT_HEADS // KV_HEADS
ATT_WIDTH = ATT_HEADS * HEAD_DIM
KV_WIDTH = KV_HEADS * HEAD_DIM
RWKV_HEADS = 8
RWKV_WIDTH = RWKV_HEADS * HEAD_DIM
MIX_WIDTH = ATT_WIDTH + RWKV_WIDTH
WINDOW = 128
BLOCK = 128
DECAY_LORA = 64
ICL_LORA = 64
GATE_LORA = 128
RWKV_BLOCK = 3 * RWKV_WIDTH + DECAY_LORA + ICL_LORA + GATE_LORA
ATT_PROJ = ATT_WIDTH + 2 * KV_WIDTH
PROJ_WIDTH = ATT_PROJ + RWKV_BLOCK
D_FF = -(-8 * D_MODEL // (3 * 256)) * 256
RMS_EPS = 1e-6
GN_EPS = 64e-5
L2_EPS = 1e-12
NEG_INF = -1e30

PROJ_SPLITS = [ATT_WIDTH, ATT_WIDTH + KV_WIDTH, ATT_PROJ]
RWKV_SPLITS = [RWKV_WIDTH, 2 * RWKV_WIDTH, 3 * RWKV_WIDTH,
               3 * RWKV_WIDTH + DECAY_LORA, 3 * RWKV_WIDTH + DECAY_LORA + ICL_LORA]

kernel_name = "hymba_swa_sink_rwkv7_decode_step"


def rmsnorm(x, g):
    xf = x.astype(jnp.float32)
    y = xf * lax.rsqrt(jnp.mean(xf * xf, axis=-1, keepdims=True) + RMS_EPS)
    return (y * g.astype(jnp.float32)).astype(x.dtype)


def attend_with_sinks(q, k, v, mask, sinks):
    s = jnp.einsum('...qkgd,...skd->...kgqs', q, k).astype(jnp.float32) * (HEAD_DIM ** -0.5)
    s = jnp.where(mask, s, NEG_INF)
    sink = jnp.broadcast_to(sinks.astype(jnp.float32).reshape(KV_HEADS, Q_PER_KV, 1, 1),
                            s.shape[:-1] + (1,))
    p = jax.nn.softmax(jnp.concatenate([s, sink], axis=-1), axis=-1)[..., :-1]
    return jnp.einsum('...kgqs,...skd->...qkgd', p.astype(v.dtype), v)


def swa_prompt(q, k, v, sinks):
    B, T = q.shape[0], q.shape[1]
    nb = T // BLOCK
    qb = q.reshape(B, nb, BLOCK, KV_HEADS, Q_PER_KV, HEAD_DIM)
    kb = k.reshape(B, nb, BLOCK, KV_HEADS, HEAD_DIM)
    vb = v.reshape(B, nb, BLOCK, KV_HEADS, HEAD_DIM)
    pad = ((0, 0), (1, 0), (0, 0), (0, 0), (0, 0))
    kk = jnp.concatenate([jnp.pad(kb, pad)[:, :-1], kb], axis=2)
    vv = jnp.concatenate([jnp.pad(vb, pad)[:, :-1], vb], axis=2)
    qi = jnp.arange(BLOCK)[:, None] + BLOCK
    kj = jnp.arange(2 * BLOCK)[None, :]
    band = (kj <= qi) & (qi - kj < WINDOW)
    first = (jnp.arange(nb) == 0)[:, None, None]
    mask = band[None] & ~(first & (kj < BLOCK)[None])
    o = attend_with_sinks(qb, kk, vv, mask[:, None, None], sinks)
    return o.reshape(B, T, ATT_WIDTH)


def swa_sample(q, k, v, k_buf, v_buf, sinks):
    B, T = q.shape[0], q.shape[1]
    wb = k_buf.shape[1]
    kk = jnp.concatenate([k_buf.astype(k.dtype), k], axis=1)
    vv = jnp.concatenate([v_buf.astype(v.dtype), v], axis=1)
    q_rel = wb + jnp.arange(T)[:, None]
    k_rel = jnp.arange(wb + T)[None, :]
    mask = (k_rel <= q_rel) & (q_rel - k_rel < WINDOW)
    o = attend_with_sinks(q.reshape(B, T, KV_HEADS, Q_PER_KV, HEAD_DIM), kk, vv, mask, sinks)
    return o.reshape(B, T, ATT_WIDTH), kk[:, -wb:], vv[:, -wb:]


def wkv_scan(S0, r, decay, k, v, a, b):
    def step(S, inp):
        r_t, w_t, k_t, v_t, a_t, b_t = inp
        sa = jnp.einsum('bhvk,bhk->bhv', S, a_t)
        S = S * w_t[:, :, None, :] + sa[..., None] * b_t[:, :, None, :] + v_t[..., None] * k_t[:, :, None, :]
        return S, jnp.einsum('bhvk,bhk->bhv', S, r_t)
    xs = tuple(jnp.moveaxis(t, 1, 0) for t in (r, decay, k, v, a, b))
    S, o = lax.scan(step, S0, xs)
    return jnp.moveaxis(o, 0, 1), S


def rwkv_mix(feat, feat_prev, S0, mu, w0, w2, a0, a2, g2, k_k, k_a, r_k, gn_g, gn_b):
    B, T = feat.shape[0], feat.shape[1]
    f = feat.astype(jnp.float32)
    prev = jnp.concatenate([feat_prev.astype(jnp.float32)[:, None], f[:, :-1]], axis=1)
    xs = f + (prev - f) * mu
    r, k, v, wl, al, gl = jnp.split(xs, RWKV_SPLITS, axis=-1)
    w = -jax.nn.softplus(-(w0 + jnp.tanh(wl) @ w2)) - 0.5
    decay = jnp.exp(-jnp.exp(w))
    a = jax.nn.sigmoid(a0 + al @ a2)
    g = jax.nn.sigmoid(gl) @ g2
    heads = lambda t: t.reshape(B, T, RWKV_HEADS, HEAD_DIM)
    kk = heads(k * k_k)
    kk = kk * lax.rsqrt(jnp.sum(kk * kk, axis=-1, keepdims=True) + L2_EPS)
    k = k * (1.0 + (a - 1.0) * k_a)
    rh, kh, vh, ah = heads(r), heads(k), heads(v), heads(a)
    o, S = wkv_scan(S0.astype(jnp.float32), rh, heads(decay), kh, vh, -kk, kk * ah)
    mean = jnp.mean(o, axis=-1, keepdims=True)
    var = jnp.mean(jnp.square(o - mean), axis=-1, keepdims=True)
    on = ((o - mean) * lax.rsqrt(var + GN_EPS)).reshape(B, T, RWKV_WIDTH) * gn_g + gn_b
    bonus = (jnp.sum(rh * kh * r_k, axis=-1, keepdims=True) * vh).reshape(B, T, RWKV_WIDTH)
    return ((on + bonus) * g).astype(feat.dtype), S


def hybrid_layer(x, h_prev, k_buf, v_buf, S0, g_mix, w_in, attn_sinks, rwkv_mu, w0, w2, a0, a2, g2,
                 k_k, k_a, r_k, gn_g, gn_b, w_out, g_ffn, w_gate, w_up, w_down):
    B, T = x.shape[0], x.shape[1]
    h = rmsnorm(x, g_mix)
    proj = h @ w_in
    q, k, v, feat = jnp.split(proj, PROJ_SPLITS, axis=-1)
    k = k.reshape(B, T, KV_HEADS, HEAD_DIM)
    v = v.reshape(B, T, KV_HEADS, HEAD_DIM)
    if k_buf is None:
        att = swa_prompt(q, k, v, attn_sinks)
        wp = min(WINDOW, T)
        k_win, v_win = k[:, T - wp:], v[:, T - wp:]
        feat_prev = jnp.zeros((B, RWKV_BLOCK), feat.dtype)
        S0 = jnp.zeros((B, RWKV_HEADS, HEAD_DIM, HEAD_DIM), jnp.float32)
    else:
        att, k_win, v_win = swa_sample(q, k, v, k_buf, v_buf, attn_sinks)
        feat_prev = h_prev.astype(h.dtype) @ w_in[:, ATT_PROJ:]
    rw, S = rwkv_mix(feat, feat_prev, S0, rwkv_mu, w0, w2, a0, a2, g2, k_k, k_a, r_k, gn_g, gn_b)
    x = x + jnp.concatenate([att, rw], axis=-1) @ w_out
    u = rmsnorm(x, g_ffn)
    x = x + (jax.nn.silu(u @ w_gate) * (u @ w_up)) @ w_down
    return x, k_win, v_win, S, h[:, -1]


def setup_inputs(seed: int = 0) -> dict:
    key = jax.random.key(seed)
    ks = jax.random.split(key, 32)
    nrm = lambda i, shape, scale: jax.random.normal(ks[i], shape, jnp.float32) * scale
    wb = min(WINDOW, PAST_LEN)
    return {
        "x_prompt": nrm(0, (BATCH, SEQ, D_MODEL), 1.0),
        "x_sample": nrm(1, (DEC_BATCH, DEC_SEQ, D_MODEL), 1.0),
        "cache_k": nrm(2, (DEPTH, DEC_BATCH, wb, KV_HEADS, HEAD_DIM), 1.0),
        "cache_v": nrm(3, (DEPTH, DEC_BATCH, wb, KV_HEADS, HEAD_DIM), 1.0),
        "state_wkv": nrm(4, (DEPTH, DEC_BATCH, RWKV_HEADS, HEAD_DIM, HEAD_DIM), 0.3),
        "state_shift": nrm(5, (DEPTH, DEC_BATCH, D_MODEL), 1.0),
        "g_mix": 1.0 + nrm(6, (DEPTH, D_MODEL), 0.05),
        "w_in": nrm(7, (DEPTH, D_MODEL, PROJ_WIDTH), D_MODEL ** -0.5),
        "attn_sinks": nrm(8, (DEPTH, ATT_HEADS), 1.0),
        "rwkv_mu": jax.random.uniform(ks[9], (DEPTH, RWKV_BLOCK), jnp.float32),
        "w0": jax.random.uniform(ks[10], (DEPTH, RWKV_WIDTH), jnp.float32, -6.0, -1.0),
        "w2": nrm(11, (DEPTH, DECAY_LORA, RWKV_WIDTH), 0.5 * DECAY_LORA ** -0.5),
        "a0": nrm(12, (DEPTH, RWKV_WIDTH), 0.1),
        "a2": nrm(13, (DEPTH, ICL_LORA, RWKV_WIDTH), 0.5 * ICL_LORA ** -0.5),
        "g2": nrm(14, (DEPTH, GATE_LORA, RWKV_WIDTH), GATE_LORA ** -0.5),
        "k_k": 0.85 + nrm(15, (DEPTH, RWKV_WIDTH), 0.05),
        "k_a": 1.0 + nrm(16, (DEPTH, RWKV_WIDTH), 0.05),
        "r_k": nrm(17, (DEPTH, RWKV_HEADS, HEAD_DIM), 0.1),
        "gn_g": 1.0 + nrm(18, (DEPTH, RWKV_WIDTH), 0.05),
        "gn_b": nrm(19, (DEPTH, RWKV_WIDTH), 0.02),
        "w_out": nrm(20, (DEPTH, MIX_WIDTH, D_MODEL), MIX_WIDTH ** -0.5),
        "g_ffn": 1.0 + nrm(21, (DEPTH, D_MODEL), 0.05),
        "w_gate": nrm(22, (DEPTH, D_MODEL, D_FF), D_MODEL ** -0.5),
        "w_up": nrm(23, (DEPTH, D_MODEL, D_FF), D_MODEL ** -0.5),
        "w_down": nrm(24, (DEPTH, D_FF, D_MODEL), D_FF ** -0.5),
        "g_final": 1.0 + nrm(25, (D_MODEL,), 0.05),
    }


def reference(x_prompt, x_sample, cache_k, cache_v, state_wkv, state_shift, g_mix, w_in, attn_sinks,
              rwkv_mu, w0, w2, a0, a2, g2, k_k, k_a, r_k, gn_g, gn_b, w_out, g_ffn, w_gate, w_up,
              w_down, g_final):
    xp, xs = x_prompt, x_sample
    kp_l, vp_l, sp_l, hp_l = [], [], [], []
    ks_l, vs_l, ss_l, hs_l = [], [], [], []
    for l in range(DEPTH):
        ws = (g_mix[l], w_in[l], attn_sinks[l], rwkv_mu[l], w0[l], w2[l], a0[l], a2[l], g2[l],
              k_k[l], k_a[l], r_k[l], gn_g[l], gn_b[l], w_out[l], g_ffn[l], w_gate[l], w_up[l], w_down[l])
        xp, kp, vp, sp, hp = hybrid_layer(xp, None, None, None, None, *ws)
        xs, kn, vn, sn, hn = hybrid_layer(xs, state_shift[l], cache_k[l], cache_v[l], state_wkv[l], *ws)
        kp_l.append(kp); vp_l.append(vp); sp_l.append(sp.astype(x_prompt.dtype)); hp_l.append(hp)
        ks_l.append(kn); vs_l.append(vn); ss_l.append(sn.astype(state_wkv.dtype)); hs_l.append(hn)
    y_prompt = rmsnorm(xp, g_final)
    y_sample = rmsnorm(xs, g_final)
    return (y_prompt, y_sample,
            jnp.stack(kp_l), jnp.stack(vp_l), jnp.stack(sp_l), jnp.stack(hp_l),
            jnp.stack(ks_l), jnp.stack(vs_l), jnp.stack(ss_l), jnp.stack(hs_l))
```

```cpp
#include <hip/hip_runtime.h>
#include <hip/hip_cooperative_groups.h>
#include <cstdio>
namespace cg = cooperative_groups;
namespace pg8 {
#define PG8_LAS __attribute__((address_space(3)))
typedef unsigned short bf16_t;
typedef short bf16x8 __attribute__((ext_vector_type(8)));
typedef float f32x4 __attribute__((ext_vector_type(4)));
typedef unsigned u32x4 __attribute__((ext_vector_type(4)));
constexpr int BM = 256, BK = 64, HALF = 128, HTB = HALF * BK * 2  , STAGE_BYTES = 8 * HTB, NXCD = 8, WGM = 8;

__host__ __device__ __forceinline__ int lds_byte(int r, int c) { const int st = (r >> 4) * 2 + (c >> 5), rr = r & 15, cc = c & 31, ob = rr * 64 + cc * 2; return st * 1024 + (ob ^ (((ob >> 9) & 1) << 5)); }
__host__ __device__ __forceinline__ void stage_rc(int b, int& R, int& C) { const int st = b / 1024, sb = b % 1024, swz = sb ^ (((sb >> 9) & 1) << 5); R = (st >> 1) * 16 + swz / 64; C = (st & 1) * 32 + (swz % 64) / 2; }
__host__ __device__ __forceinline__ int perm32(int rho) { const int n = rho >> 4, i = rho & 15; return 8 * (i >> 2) + 4 * n + (i & 3); }

struct Unit { int pm, pn; };
struct Gemm { const bf16_t* A; const bf16_t* Bt; int M, N, K; };

struct StaticOrder {
    int nM, nN, nwg, G, c;
    __host__ __device__ void init(int M, int N, int G_, int c_) { nM = M / BM; nN = N / BM; nwg = nM * nN; G = G_; c = c_; }
    __host__ __device__ bool next(int i, Unit& u) const {
        const long L = (long)i * G + c; if (L >= nwg) return false;
        int wgid = (int)L; { const int q = nwg / NXCD, r = nwg % NXCD, xcd = wgid % NXCD, off = wgid / NXCD; wgid = (xcd < r ? xcd * (q + 1) : r * (q + 1) + (xcd - r) * q) + off; }
        const int nig = WGM * nN, gid = wgid / nig, fm = gid * WGM, gsz = (nM - fm) < WGM ? (nM - fm) : WGM;
        u.pm = fm + ((wgid % nig) % gsz); u.pn = (wgid % nig) / gsz; return true;
    }
    __device__ __forceinline__ void a_ready(const Unit&) const {}
    __device__ __forceinline__ void done(const Unit&) const {}
};
__device__ __forceinline__ unsigned cvt_pk_bf16(float lo, float hi) { unsigned r; asm volatile("v_cvt_pk_bf16_f32 %0, %1, %2" : "=v"(r) : "v"(lo), "v"(hi)); return r; }
struct EpiProj {
    static constexpr bool PERM = true, AFTER_DRAIN = false;
    bf16_t* O; float* kwp; float* vwp; float* kws; float* vws;
    __device__ __forceinline__ void operator()(const f32x4 (&acc)[2][2][4][2], const Unit& u, int wr, int wc, int fr, int fq) const {
        const int row0 = u.pm * BM + wr * 64 + fr; const int col0 = u.pn * BM + wc * 32 + 8 * fq;
#pragma unroll
        for (int ai = 0; ai < 2; ++ai)
#pragma unroll
            for (int m = 0; m < 4; ++m) { const int row = row0 + ai * HALF + m * 16; bf16_t* rowp = O + (size_t)row * 2560 + col0;
#pragma unroll
                for (int bj = 0; bj < 2; ++bj) { const f32x4 v0 = acc[ai][bj][m][0], v1 = acc[ai][bj][m][1];
                    u32x4 w; w.x = cvt_pk_bf16(v0[0], v0[1]); w.y = cvt_pk_bf16(v0[2], v0[3]); w.z = cvt_pk_bf16(v1[0], v1[1]); w.w = cvt_pk_bf16(v1[2], v1[3]);
                    *(u32x4*)(rowp + bj * HALF) = w; }
                if (u.pn == 2) {
                    int off = -1; bool smp = false;
                    if (row < 16384) { const int t = row & 8191; if (t >= 8064) off = (((row >> 13) * 128) + (t - 8064)) * 128; }
                    else if (row < 17408) { const int s = row - 16384; off = (((s >> 3) * 128) + 120 + (s & 7)) * 128; smp = true; }
                    if (off >= 0) {
#pragma unroll
                        for (int bj = 0; bj < 2; ++bj) { float* d = (smp ? (bj ? vws : kws) : (bj ? vwp : kwp)) + off + wc * 32 + 8 * fq;
                            *(f32x4*)d = acc[ai][bj][m][0]; *(f32x4*)(d + 4) = acc[ai][bj][m][1]; }
                    }
                }
            }
    }
};
template <bool FIRST> struct EpiRes {
    static constexpr bool PERM = false, AFTER_DRAIN = false;
    const float* xin;
    const float* xin2; float* X; bf16_t* XB; float* ss;
    __device__ __forceinline__ void operator()(const f32x4 (&acc)[2][2][4][2], const Unit& u, int wr, int wc, int fr, int fq) const {
        const int row0 = u.pm * BM + wr * 64 + fr, col0 = u.pn * BM + wc * 32 + 4 * fq;
#pragma unroll
        for (int ai = 0; ai < 2; ++ai)
#pragma unroll
            for (int m = 0; m < 4; ++m) { const int row = row0 + ai * HALF + m * 16;
                const float* xr = FIRST ? (row < 16384 ? xin + (size_t)row * 1024 : xin2 + (size_t)(row - 16384) * 1024) : xin + (size_t)row * 1024;
                float sq = 0.f;
#pragma unroll
                for (int bj = 0; bj < 2; ++bj)
#pragma unroll
                    for (int n = 0; n < 2; ++n) { const int c = col0 + bj * HALF + n * 16; f32x4 v = acc[ai][bj][m][n] + *(const f32x4*)(xr + c);
                        *(f32x4*)(X + (size_t)row * 1024 + c) = v; sq += v[0] * v[0] + v[1] * v[1] + v[2] * v[2] + v[3] * v[3];
                        if (FIRST) { unsigned lo = cvt_pk_bf16(v[0], v[1]), hi = cvt_pk_bf16(v[2], v[3]); uint2 w; w.x = lo; w.y = hi; *(uint2*)(XB + (size_t)row * 1024 + c) = w; } }
                sq += __shfl_xor(sq, 16); sq += __shfl_xor(sq, 32);
                if (fq == 0) atomicAdd(ss + row, sq);
            }
    }
};
struct EpiAct {
    static constexpr bool PERM = true, AFTER_DRAIN = false;
    bf16_t* ACT; const float* ss;
    __device__ __forceinline__ void operator()(const f32x4 (&acc)[2][2][4][2], const Unit& u, int wr, int wc, int fr, int fq) const {
        const int row0 = u.pm * BM + wr * 64 + fr, col0 = u.pn * 128 + wc * 32 + 8 * fq;
#pragma unroll
        for (int ai = 0; ai < 2; ++ai)
#pragma unroll
            for (int m = 0; m < 4; ++m) { const int row = row0 + ai * HALF + m * 16; const float rstd = rsqrtf(ss[row] * (1.0f / 1024.0f) + 1e-6f);
                float a[8];
#pragma unroll
                for (int n = 0; n < 2; ++n)
#pragma unroll
                    for (int j = 0; j < 4; ++j) { const float g = acc[ai][0][m][n][j] * rstd, up = acc[ai][1][m][n][j] * rstd; a[4 * n + j] = g / (1.0f + __expf(-g)) * up; }
                u32x4 w; w.x = cvt_pk_bf16(a[0], a[1]); w.y = cvt_pk_bf16(a[2], a[3]); w.z = cvt_pk_bf16(a[4], a[5]); w.w = cvt_pk_bf16(a[6], a[7]);
                *(u32x4*)(ACT + (size_t)row * 2816 + col0) = w; }
    }
};

template <class Epi, class Sched, bool STAMP = false>
__device__ __forceinline__ void gemm_phase(PG8_LAS unsigned char* lds, const Gemm g, const Sched& S, const Epi& E, unsigned long long* stamps) {
    const int tid = threadIdx.x, wid = __builtin_amdgcn_readfirstlane(tid >> 6), lane = tid & 63, wr = wid >> 2, wc = wid & 3, fr = lane & 15, fq = lane >> 4;
    const int K = g.K, nt = K / BK;
    int ts_lo = 0, ts_hi = 0, nts = 0; const unsigned long long rt_entry = STAMP ? (unsigned long long)wall_clock64() : 0ull;
#define PG8_STAMP() do { if (STAMP && wid == 0 && nts < 64) { const unsigned long long _c = (unsigned long long)clock64(); \
        ts_lo = (lane == nts) ? (int)(unsigned)_c : ts_lo; ts_hi = (lane == nts) ? (int)(unsigned)(_c >> 32) : ts_hi; ++nts; } } while (0)
    PG8_STAMP();
    unsigned voffA[2], voffB[2];
#pragma unroll
    for (int i = 0; i < 2; ++i) { int R, C; stage_rc(tid * 16 + i * 8192, R, C); const int Rb = Epi::PERM ? ((R & ~31) + perm32(R & 31)) : R;
        voffA[i] = (unsigned)(R * K + C) * 2u; voffB[i] = (unsigned)(Rb * K + C) * 2u; }
    const size_t kstep = (size_t)(BK * 2);
    const size_t hstep = (size_t)HALF * K * 2;
    const size_t tstep = 2 * hstep;
    const unsigned ldsw = (unsigned)wid * 1024u;
    const int aoff = lds_byte(wr * 64 + fr, fq * 8), boff = lds_byte(wc * 32 + fr, fq * 8);
#define PG8_SA(b, h) (((b) * 2 + (h)) * HTB)
#define PG8_SB(b, h) ((4 + (b) * 2 + (h)) * HTB)
#define PG8_STAGE(bufoff, gbase, voff) do { _Pragma("unroll") for (int _i = 0; _i < 2; ++_i) \
        __builtin_amdgcn_global_load_lds((const unsigned*)((const char*)(gbase) + (voff)[_i]), (PG8_LAS unsigned*)(lds + (bufoff) + ldsw + _i * 8192), 16, 0, 0); } while (0)
#define PG8_LDA(dst, b, h) do { _Pragma("unroll") for (int m = 0; m < 4; ++m) _Pragma("unroll") for (int k = 0; k < 2; ++k) dst[m][k] = *(const PG8_LAS bf16x8*)(lds + PG8_SA(b, h) + aoff + m * 2048 + k * 1024); } while (0)
#define PG8_LDB(dst, b, h) do { _Pragma("unroll") for (int n = 0; n < 2; ++n) _Pragma("unroll") for (int k = 0; k < 2; ++k) dst[n][k] = *(const PG8_LAS bf16x8*)(lds + PG8_SB(b, h) + boff + n * 2048 + k * 1024); } while (0)
#define PG8_MMA(ai, bj, At, Bt) do { __builtin_amdgcn_s_setprio(1); _Pragma("unroll") for (int m = 0; m < 4; ++m) _Pragma("unroll") for (int n = 0; n < 2; ++n) _Pragma("unroll") for (int k = 0; k < 2; ++k) \
        acc[ai][bj][m][n] = __builtin_amdgcn_mfma_f32_16x16x32_bf16(Bt[n][k], At[m][k], acc[ai][bj][m][n], 0, 0, 0); __builtin_amdgcn_s_setprio(0); } while (0)
#define PG8_WAIT_V(n) asm volatile("s_waitcnt vmcnt(" #n ")" ::: "memory")
#define PG8_WAIT_L(n) asm volatile("s_waitcnt lgkmcnt(" #n ")" ::: "memory")
#define PG8_BAR __builtin_amdgcn_s_barrier()
#define PG8_SCHED __builtin_amdgcn_sched_barrier(0)
    Unit cur, nxt; int ui = 0;
    if (!S.next(0, cur)) return;
    f32x4 acc[2][2][4][2];
#pragma unroll
    for (int a = 0; a < 2; ++a)
#pragma unroll
        for (int b = 0; b < 2; ++b)
#pragma unroll
            for (int m = 0; m < 4; ++m)
#pragma unroll
                for (int n = 0; n < 2; ++n) acc[a][b][m][n] = (f32x4){0.f, 0.f, 0.f, 0.f};
    bf16x8 At[4][2], B0[2][2], B1[2][2];
    const char* cA = (const char*)g.A + (size_t)cur.pm * tstep; const char* cB = (const char*)g.Bt + (size_t)cur.pn * tstep;
    S.a_ready(cur);
    PG8_STAGE(PG8_SB(0, 0), cB, voffB); PG8_STAGE(PG8_SA(0, 0), cA, voffA); PG8_STAGE(PG8_SB(0, 1), cB + hstep, voffB); PG8_STAGE(PG8_SA(0, 1), cA + hstep, voffA);
    if (wr == 1) PG8_BAR;
    PG8_WAIT_V(4); PG8_BAR;
    PG8_STAGE(PG8_SB(1, 0), cB + kstep, voffB); PG8_STAGE(PG8_SA(1, 0), cA + kstep, voffA); PG8_STAGE(PG8_SB(1, 1), cB + hstep + kstep, voffB);
    PG8_WAIT_V(6); PG8_BAR;
    PG8_STAMP();
    for (;;) {
        const bool has_next = S.next(ui + 1, nxt);
        const char* nA = has_next ? (const char*)g.A + (size_t)nxt.pm * tstep : cA; const char* nB = has_next ? (const char*)g.Bt + (size_t)nxt.pn * tstep : cB;
        for (int t = 0; t < nt; t += 2) {
            const bool last = (t == nt - 2);
            const char* a1 = cA + (size_t)(t + 1) * kstep;
            const char* a2 = last ? nA : cA + (size_t)(t + 2) * kstep; const char* b2 = last ? nB : cB + (size_t)(t + 2) * kstep;
            const char* a3 = a2 + kstep; const char* b3 = b2 + kstep;
            if (last && has_next) S.a_ready(nxt);
            PG8_LDB(B0, 0, 0); PG8_SCHED; PG8_LDA(At, 0, 0); PG8_STAGE(PG8_SA(1, 1), a1 + hstep, voffA);
            PG8_WAIT_L(8); PG8_BAR; PG8_WAIT_L(0); PG8_MMA(0, 0, At, B0); PG8_BAR; PG8_SCHED;
            PG8_LDB(B1, 0, 1); PG8_STAGE(PG8_SB(0, 0), b2, voffB);
            PG8_BAR; PG8_WAIT_L(0); PG8_MMA(0, 1, At, B1); PG8_BAR;
            PG8_LDA(At, 0, 1); PG8_STAGE(PG8_SA(0, 0), a2, voffA);
            PG8_BAR; PG8_WAIT_L(0); PG8_MMA(1, 0, At, B0); PG8_BAR; PG8_SCHED;
            PG8_STAGE(PG8_SB(0, 1), b2 + hstep, voffB);
            PG8_WAIT_V(6); PG8_BAR; PG8_MMA(1, 1, At, B1); PG8_BAR;
            PG8_LDB(B0, 1, 0); PG8_SCHED; PG8_LDA(At, 1, 0); PG8_STAGE(PG8_SA(0, 1), a2 + hstep, voffA);
            PG8_WAIT_L(8); PG8_BAR; PG8_WAIT_L(0); PG8_MMA(0, 0, At, B0); PG8_BAR; PG8_SCHED;
            PG8_LDB(B1, 1, 1); PG8_STAGE(PG8_SB(1, 0), b3, voffB);
            PG8_BAR; PG8_WAIT_L(0); PG8_MMA(0, 1, At, B1); PG8_BAR;
            PG8_LDA(At, 1, 1); PG8_STAGE(PG8_SA(1, 0), a3, voffA);
            PG8_BAR; PG8_WAIT_L(0); PG8_MMA(1, 0, At, B0); PG8_BAR; PG8_SCHED;
            PG8_STAGE(PG8_SB(1, 1), b3 + hstep, voffB);
            PG8_WAIT_V(6); PG8_BAR; PG8_MMA(1, 1, At, B1); PG8_BAR;
        }
        PG8_STAMP();
        if constexpr (!Epi::AFTER_DRAIN) { E(acc, cur, wr, wc, fr, fq); S.done(cur); }
        PG8_STAMP();
        if (!has_next) break;
#pragma unroll
        for (int a = 0; a < 2; ++a)
#pragma unroll
            for (int b = 0; b < 2; ++b)
#pragma unroll
                for (int m = 0; m < 4; ++m)
#pragma unroll
                    for (int n = 0; n < 2; ++n) acc[a][b][m][n] = (f32x4){0.f, 0.f, 0.f, 0.f};
        cur = nxt; cA = nA; cB = nB; ++ui;
    }
    PG8_WAIT_V(0);
    if (wr == 0) PG8_BAR;
    PG8_BAR;
    if constexpr (Epi::AFTER_DRAIN) { E.fused(acc, cur, wr, wc, fr, fq, lds, wid, lane); S.done(cur); }
    PG8_STAMP();
    if (STAMP && wid == 0) { stamps[lane] = lane < nts ? (((unsigned long long)(unsigned)ts_hi << 32) | (unsigned)ts_lo) : 0ull;
        if (lane == 62) stamps[62] = rt_entry; if (lane == 63) stamps[63] = (unsigned long long)wall_clock64(); }
#undef PG8_STAMP
#undef PG8_SA
#undef PG8_SB
#undef PG8_STAGE
#undef PG8_LDA
#undef PG8_LDB
#undef PG8_MMA
#undef PG8_WAIT_V
#undef PG8_WAIT_L
#undef PG8_BAR
#undef PG8_SCHED
}
}
#define DI __device__ __forceinline__
typedef unsigned short bf16_t;
typedef short bf16x8 __attribute__((ext_vector_type(8)));
typedef short s16x4 __attribute__((ext_vector_type(4)));
typedef float f32x4 __attribute__((ext_vector_type(4)));
typedef float f32x16 __attribute__((ext_vector_type(16)));
typedef unsigned u32x4 __attribute__((ext_vector_type(4)));
typedef float f32x2v __attribute__((ext_vector_type(2)));
typedef __bf16 bf2v __attribute__((ext_vector_type(2)));
#define MFMA32(a, b, c) __builtin_amdgcn_mfma_f32_32x32x16_bf16((a), (b), (c), 0, 0, 0)

constexpr int NP = 16384, NTOK = 17408, M1 = 17664, LDS_BYTES = 131072, NTHREADS = 512;
constexpr size_t WS_WIN = 0, WS_WOUT = 5242880, WS_WGU = 7340032, WS_WD = 18874368, WS_W2T = 24641536, WS_A2T = WS_W2T + 65536, WS_G2T = WS_A2T + 65536,
    WS_SS1 = 24903680, WS_SS2 = WS_SS1 + 69632, WS_BONUS = 25042944, WS_PROJ = 25600000, WS_RW = 116039680, RWB = 17825792  ,
    WS_R = WS_RW, WS_K = WS_RW + RWB, WS_V = WS_RW + 2 * RWB, WS_A = WS_RW + 3 * RWB, WS_B = WS_RW + 4 * RWB, WS_G = WS_RW + 5 * RWB, WS_W = WS_RW + 6 * RWB,
    WS_X1 = 25600000, WS_X1B = 96903168, WS_ACT = 132554752;
constexpr size_t O_Y = 0, O_KWP = 17825792, O_VWP = O_KWP + 32768, O_SP = O_VWP + 32768, O_HP = O_SP + 65536, O_KWS = O_HP + 2048, O_VWS = O_KWS + 2097152, O_SS = O_VWS + 2097152, O_HS = O_SS + 4194304;

struct Params { const float* in[26]; float* out; unsigned char* ws; };
enum { I_XP = 0, I_XS, I_CK, I_CV, I_SW, I_SH, I_GMIX, I_WIN, I_SINK, I_MU, I_W0, I_W2, I_A0, I_A2, I_G2, I_KK, I_KA, I_RK, I_GNG, I_GNB, I_WOUT, I_GFFN, I_WG, I_WU, I_WD, I_GFIN };

DI unsigned pk2(float a, float b) { f32x2v v = {a, b}; return __builtin_bit_cast(unsigned, __builtin_convertvector(v, bf2v)); }
DI float bflo(unsigned u) { return __uint_as_float(u << 16); }
DI float bfhi(unsigned u) { return __uint_as_float(u & 0xffff0000u); }
DI float bf1(bf16_t u) { return __uint_as_float(((unsigned)u) << 16); }
DI float sigmoidf_(float x) { return 1.0f / (1.0f + __expf(-x)); }
DI int prev_row(int m) {
    if (m < NP) return (m & 8191) == 0 ? -1 : m - 1;
    const int s = m - NP; return (s & 7) == 0 ? NTOK + (s >> 3) : m - 1;
}

DI void tr_tile(const float* __restrict__ src, int ldn, int k0, int n0, bf16_t* __restrict__ dst, int ldk, int drow0, const float* __restrict__ scale) {
    extern __shared__ __attribute__((aligned(16))) unsigned char shm[]; float* T = (float*)shm;
    const int tid = threadIdx.x; { const int r = tid >> 3, c8 = (tid & 7) * 8; const float* s = src + (size_t)(k0 + r) * ldn + n0 + c8;
        const float4 a = *(const float4*)s, b = *(const float4*)(s + 4); const float sc = scale ? scale[k0 + r] : 1.f; float* t = T + r * 65 + c8;
        t[0] = a.x * sc; t[1] = a.y * sc; t[2] = a.z * sc; t[3] = a.w * sc; t[4] = b.x * sc; t[5] = b.y * sc; t[6] = b.z * sc; t[7] = b.w * sc; }
    __syncthreads();
    { const int n = tid >> 3, k8 = (tid & 7) * 8; float v[8];
#pragma unroll
        for (int j = 0; j < 8; ++j) v[j] = T[(k8 + j) * 65 + n];
        uint4 w; w.x = pk2(v[0], v[1]); w.y = pk2(v[2], v[3]); w.z = pk2(v[4], v[5]); w.w = pk2(v[6], v[7]);
        *(uint4*)(dst + (size_t)(drow0 + n) * ldk + k0 + k8) = w; }
    __syncthreads();
}
DI void phase_prep(const Params& p) {
    unsigned char* ws = p.ws; const int tid = threadIdx.x, wid = tid >> 6, lane = tid & 63;
    for (int job = blockIdx.x; job < 3040; job += gridDim.x) {
        int j = job;
        if (j < 640) { tr_tile(p.in[I_WIN], 2560, (j % 16) * 64, (j / 16) * 64, (bf16_t*)(ws + WS_WIN), 1024, (j / 16) * 64, nullptr); continue; } j -= 640;
        if (j < 256) { tr_tile(p.in[I_WOUT], 1024, (j % 16) * 64, (j / 16) * 64, (bf16_t*)(ws + WS_WOUT), 1024, (j / 16) * 64, nullptr); continue; } j -= 256;
        if (j < 1408) { const bool up = j >= 704; if (up) j -= 704; const int n0 = (j / 16) * 64; const int dr = (n0 >> 7) * 256 + (up ? 128 : 0) + (n0 & 127);
            tr_tile(p.in[up ? I_WU : I_WG], 2816, (j % 16) * 64, n0, (bf16_t*)(ws + WS_WGU), 1024, dr, p.in[I_GFFN]); continue; } j -= 1408;
        if (j < 704) { tr_tile(p.in[I_WD], 1024, (j % 44) * 64, (j / 44) * 64, (bf16_t*)(ws + WS_WD), 2816, (j / 44) * 64, nullptr); continue; } j -= 704;
        if (j < 8) { tr_tile(p.in[I_W2], 512, 0, j * 64, (bf16_t*)(ws + WS_W2T), 64, j * 64, nullptr); continue; } j -= 8;
        if (j < 8) { tr_tile(p.in[I_A2], 512, 0, j * 64, (bf16_t*)(ws + WS_A2T), 64, j * 64, nullptr); continue; } j -= 8;
        tr_tile(p.in[I_G2], 512, (j & 1) * 64, (j >> 1) * 64, (bf16_t*)(ws + WS_G2T), 128, (j >> 1) * 64, nullptr);
    }
    bf16_t* XN = (bf16_t*)p.out; const float* gm = p.in[I_GMIX];
    for (int m = blockIdx.x * 8 + wid; m < M1; m += gridDim.x * 8) {
        bf16_t* dst = XN + (size_t)m * 1024;
        if (m >= NTOK + 128) { for (int i = 0; i < 4; ++i) *(uint2*)(dst + lane * 4 + 256 * i) = make_uint2(0u, 0u); continue; }
        const float* src = m < NP ? p.in[I_XP] + (size_t)m * 1024 : (m < NTOK ? p.in[I_XS] + (size_t)(m - NP) * 1024 : p.in[I_SH] + (size_t)(m - NTOK) * 1024);
        float4 v[4]; float sq = 0.f;
#pragma unroll
        for (int i = 0; i < 4; ++i) { v[i] = *(const float4*)(src + lane * 4 + 256 * i); sq += v[i].x * v[i].x + v[i].y * v[i].y + v[i].z * v[i].z + v[i].w * v[i].w; }
        float rstd = 1.f; const bool norm = m < NTOK;
        if (norm) {
#pragma unroll
            for (int o = 32; o >= 1; o >>= 1) sq += __shfl_xor(sq, o);
            rstd = rsqrtf(sq * (1.0f / 1024.0f) + 1e-6f); }
        float* sh = nullptr;
        if (m < NP) { if ((m & 8191) == 8191) sh = p.out + O_HP + (size_t)(m >> 13) * 1024; } else if (m < NTOK) { const int s = m - NP; if ((s & 7) == 7) sh = p.out + O_HS + (size_t)(s >> 3) * 1024; }
#pragma unroll
        for (int i = 0; i < 4; ++i) { float4 h = v[i];
            if (norm) { const float4 g = *(const float4*)(gm + lane * 4 + 256 * i); h.x *= rstd * g.x; h.y *= rstd * g.y; h.z *= rstd * g.z; h.w *= rstd * g.w; }
            *(uint2*)(dst + lane * 4 + 256 * i) = make_uint2(pk2(h.x, h.y), pk2(h.z, h.w));
            if (sh) *(float4*)(sh + lane * 4 + 256 * i) = h; }
    }
    const size_t gt = (size_t)blockIdx.x * NTHREADS + tid, gs = (size_t)gridDim.x * NTHREADS;
    for (size_t i = gt; i < (size_t)2 * 128 * 3840; i += gs) { const int which = (int)(i / (128 * 3840)); const size_t r = i % (128 * 3840); const int b = (int)(r / 3840), q = (int)(r % 3840);
        const float* s = p.in[which ? I_CV : I_CK] + (size_t)b * 16384 + 1024 + q * 4; float* d = p.out + (which ? O_VWS : O_KWS) + (size_t)b * 16384 + q * 4; *(float4*)d = *(const float4*)s; }
    for (size_t i = gt; i < (size_t)2 * NTOK; i += gs) ((float*)(ws + WS_SS1))[i] = 0.f;
}

DI void load4bf(const bf16_t* p_, float (&o)[4]) { const uint2 u = *(const uint2*)p_; o[0] = bflo(u.x); o[1] = bfhi(u.x); o[2] = bflo(u.y); o[3] = bfhi(u.y); }
DI void xs4(const bf16_t* cp, const bf16_t* pp, float pf, const float* mu, float (&o)[4]) {
    float c[4], q[4]; load4bf(cp, c); load4bf(pp, q);
    const float4 u = *(const float4*)mu; o[0] = c[0] + (q[0] * pf - c[0]) * u.x; o[1] = c[1] + (q[1] * pf - c[1]) * u.y; o[2] = c[2] + (q[2] * pf - c[2]) * u.z; o[3] = c[3] + (q[3] * pf - c[3]) * u.w;
}
DI void rwkv_prep_tile(const Params& p, int tile) {
    extern __shared__ __attribute__((aligned(16))) unsigned char shm[]; bf16_t* XL = (bf16_t*)shm;
    unsigned char* ws = p.ws; const bf16_t* PROJ = (const bf16_t*)(ws + WS_PROJ); const float* mu = p.in[I_MU];
    const int tid = threadIdx.x, wid = tid >> 6, lane = tid & 63, r = lane & 31, hh = lane >> 5, m0 = tile * 64;
    for (int idx = tid; idx < 64 * 32; idx += NTHREADS) { const int tok = idx >> 5, c8 = (idx & 31) * 8, m = m0 + tok, pr = prev_row(m);
        const bf16_t* cp = PROJ + (size_t)m * 2560 + 768 + 1536 + c8; const bf16_t* pp = PROJ + (size_t)(pr >= 0 ? pr : m) * 2560 + 768 + 1536 + c8; const float pf = pr >= 0 ? 1.f : 0.f;
        float a[4], b[4]; xs4(cp, pp, pf, mu + 1536 + c8, a); xs4(cp + 4, pp + 4, pf, mu + 1536 + c8 + 4, b);
        if (c8 < 64) {
#pragma unroll
            for (int j = 0; j < 4; ++j) { a[j] = tanhf(a[j]); b[j] = tanhf(b[j]); } }
        else if (c8 >= 128) {
#pragma unroll
            for (int j = 0; j < 4; ++j) { a[j] = sigmoidf_(a[j]); b[j] = sigmoidf_(b[j]); } }
        uint4 w; w.x = pk2(a[0], a[1]); w.y = pk2(a[2], a[3]); w.z = pk2(b[0], b[1]); w.w = pk2(b[2], b[3]); *(uint4*)(XL + tok * 264 + c8) = w; }
    __syncthreads();
    const int h = wid; const bf16_t* w2t = (const bf16_t*)(ws + WS_W2T); const bf16_t* a2t = (const bf16_t*)(ws + WS_A2T); const bf16_t* g2t = (const bf16_t*)(ws + WS_G2T);
    bf16_t* Rb = (bf16_t*)(ws + WS_R); bf16_t* Kb = (bf16_t*)(ws + WS_K); bf16_t* Vb = (bf16_t*)(ws + WS_V); bf16_t* Ab = (bf16_t*)(ws + WS_A); bf16_t* Bb = (bf16_t*)(ws + WS_B); bf16_t* Gb = (bf16_t*)(ws + WS_G);
    float* Wf = (float*)(ws + WS_W); float* BON = (float*)(ws + WS_BONUS);
#pragma unroll 1
    for (int tt = 0; tt < 2; ++tt) {
        f32x16 Dw[2], Da[2], Dg[2];
#pragma unroll
        for (int ct = 0; ct < 2; ++ct)
#pragma unroll
            for (int i = 0; i < 16; ++i) { Dw[ct][i] = 0.f; Da[ct][i] = 0.f; Dg[ct][i] = 0.f; }
        const bf16_t* xrow = XL + (32 * tt + r) * 264 + 8 * hh;
#pragma unroll 1
        for (int s = 0; s < 4; ++s) { const bf16x8 xw = *(const bf16x8*)(xrow + 16 * s), xa = *(const bf16x8*)(xrow + 64 + 16 * s);
#pragma unroll
            for (int ct = 0; ct < 2; ++ct) { const int ch = h * 64 + 32 * ct + r;
                Dw[ct] = MFMA32(*(const bf16x8*)(w2t + ch * 64 + 16 * s + 8 * hh), xw, Dw[ct]); Da[ct] = MFMA32(*(const bf16x8*)(a2t + ch * 64 + 16 * s + 8 * hh), xa, Da[ct]); } }
#pragma unroll 1
        for (int s = 0; s < 8; ++s) { const bf16x8 xg = *(const bf16x8*)(xrow + 128 + 16 * s);
#pragma unroll
            for (int ct = 0; ct < 2; ++ct) { const int ch = h * 64 + 32 * ct + r; Dg[ct] = MFMA32(*(const bf16x8*)(g2t + ch * 128 + 16 * s + 8 * hh), xg, Dg[ct]); } }
        const int m = m0 + 32 * tt + r, pr = prev_row(m); const int cb = h * 64 + 4 * hh;
        const bf16_t* cp = PROJ + (size_t)m * 2560 + 768 + cb; const bf16_t* pp = PROJ + (size_t)(pr >= 0 ? pr : m) * 2560 + 768 + cb; const float pf = pr >= 0 ? 1.f : 0.f;
        const float* mub = mu + cb; const float* kkb = p.in[I_KK] + cb; const float* kab = p.in[I_KA] + cb; const float* w0b = p.in[I_W0] + cb; const float* a0b = p.in[I_A0] + cb; const float* rkb = p.in[I_RK] + cb;
        const size_t ob = (size_t)m * 512 + cb;
        float sumsq = 0.f;
#pragma unroll
        for (int ct = 0; ct < 2; ++ct)
#pragma unroll
            for (int g4 = 0; g4 < 4; ++g4) { const int c0 = 32 * ct + 8 * g4; float k4[4]; xs4(cp + 512 + c0, pp + 512 + c0, pf, mub + 512 + c0, k4); const float4 kk4 = *(const float4*)(kkb + c0);
                const float q0 = k4[0] * kk4.x, q1 = k4[1] * kk4.y, q2 = k4[2] * kk4.z, q3 = k4[3] * kk4.w; sumsq += q0 * q0 + q1 * q1 + q2 * q2 + q3 * q3;
                __builtin_amdgcn_sched_barrier(0); }
        sumsq += __shfl_xor(sumsq, 32); const float inv = rsqrtf(sumsq + 1e-12f);
        float bonus = 0.f;
#pragma unroll
        for (int ct = 0; ct < 2; ++ct)
#pragma unroll
            for (int g4 = 0; g4 < 4; ++g4) { const int c0 = 32 * ct + 8 * g4; float r4[4], v4[4], k4[4]; xs4(cp + c0, pp + c0, pf, mub + c0, r4); xs4(cp + 1024 + c0, pp + 1024 + c0, pf, mub + 1024 + c0, v4); xs4(cp + 512 + c0, pp + 512 + c0, pf, mub + 512 + c0, k4);
                const float4 kk4 = *(const float4*)(kkb + c0), ka4 = *(const float4*)(kab + c0), w04 = *(const float4*)(w0b + c0), a04 = *(const float4*)(a0b + c0), rk4 = *(const float4*)(rkb + c0);
                const float kkc[4] = {kk4.x, kk4.y, kk4.z, kk4.w}, kac[4] = {ka4.x, ka4.y, ka4.z, ka4.w}, w0c[4] = {w04.x, w04.y, w04.z, w04.w}, a0c[4] = {a04.x, a04.y, a04.z, a04.w}, rkc[4] = {rk4.x, rk4.y, rk4.z, rk4.w};
                float dec[4], km[4], an[4], bn[4], gg[4];
#pragma unroll
                for (int j = 0; j < 4; ++j) { const int i = g4 * 4 + j; const float x = -(w0c[j] + Dw[ct][i]);
                    const float sp = fmaxf(x, 0.f) + log1pf(__expf(-fabsf(x))); const float wr_ = -sp - 0.5f; dec[j] = __expf(-__expf(wr_));
                    const float as = sigmoidf_(a0c[j] + Da[ct][i]); const float kx = k4[j]; const float kkn = kx * kkc[j] * inv;
                    km[j] = kx * (1.0f + (as - 1.0f) * kac[j]); an[j] = -kkn; bn[j] = kkn * as; gg[j] = Dg[ct][i]; bonus += r4[j] * km[j] * rkc[j]; }
                const size_t o = ob + c0;
                *(uint2*)(Rb + o) = make_uint2(pk2(r4[0], r4[1]), pk2(r4[2], r4[3])); *(uint2*)(Kb + o) = make_uint2(pk2(km[0], km[1]), pk2(km[2], km[3]));
                *(uint2*)(Vb + o) = make_uint2(pk2(v4[0], v4[1]), pk2(v4[2], v4[3])); *(uint2*)(Ab + o) = make_uint2(pk2(an[0], an[1]), pk2(an[2], an[3]));
                *(uint2*)(Bb + o) = make_uint2(pk2(bn[0], bn[1]), pk2(bn[2], bn[3])); *(uint2*)(Gb + o) = make_uint2(pk2(gg[0], gg[1]), pk2(gg[2], gg[3]));
                *(float4*)(Wf + o) = make_float4(dec[0], dec[1], dec[2], dec[3]); __builtin_amdgcn_sched_barrier(0); }
        bonus += __shfl_xor(bonus, 32); if (hh == 0) BON[(size_t)m * 8 + h] = bonus;
    }
    __syncthreads();
}

DI void attn_wave_tile(const bf16_t* Ks, const bf16_t* Vt, int j0, const bf16_t* qptr, int lo, int hi, float sink, bf16_t* optr) {
    const int lane = threadIdx.x & 63, r = lane & 31, hh = lane >> 5;
    bf16x8 qf[4];
#pragma unroll
    for (int s = 0; s < 4; ++s) qf[s] = *(const bf16x8*)(qptr + 16 * s + 8 * hh);
    f32x16 sc[5];
#pragma unroll
    for (int kt = 0; kt < 5; ++kt) {
#pragma unroll
        for (int i = 0; i < 16; ++i) sc[kt][i] = 0.f;
#pragma unroll
        for (int s = 0; s < 4; ++s) sc[kt] = MFMA32(*(const bf16x8*)(Ks + (j0 + 32 * kt + r) * 72 + 16 * s + 8 * hh), qf[s], sc[kt]); }
    float mx = sink;
#pragma unroll
    for (int kt = 0; kt < 5; ++kt)
#pragma unroll
        for (int i = 0; i < 16; ++i) { const int j = j0 + 32 * kt + (i & 3) + 8 * (i >> 2) + 4 * hh; const bool ok = (j >= lo) && (j <= hi); const float s = ok ? sc[kt][i] * 0.125f : -1e30f; sc[kt][i] = s; mx = fmaxf(mx, s); }
    mx = fmaxf(mx, __shfl_xor(mx, 32));
    float sum = 0.f;
#pragma unroll
    for (int kt = 0; kt < 5; ++kt)
#pragma unroll
        for (int i = 0; i < 16; ++i) { const float e = __expf(sc[kt][i] - mx); sc[kt][i] = e; sum += e; }
    sum += __shfl_xor(sum, 32); sum += __expf(sink - mx); const float inv = 1.0f / sum;
    f32x16 o[2];
#pragma unroll
    for (int i = 0; i < 16; ++i) { o[0][i] = 0.f; o[1][i] = 0.f; }
#pragma unroll
    for (int kt = 0; kt < 5; ++kt)
#pragma unroll
        for (int s2 = 0; s2 < 2; ++s2) { u32x4 pw; pw.x = pk2(sc[kt][8 * s2 + 0] * inv, sc[kt][8 * s2 + 1] * inv); pw.y = pk2(sc[kt][8 * s2 + 2] * inv, sc[kt][8 * s2 + 3] * inv);
            pw.z = pk2(sc[kt][8 * s2 + 4] * inv, sc[kt][8 * s2 + 5] * inv); pw.w = pk2(sc[kt][8 * s2 + 6] * inv, sc[kt][8 * s2 + 7] * inv); const bf16x8 pb = __builtin_bit_cast(bf16x8, pw);
#pragma unroll
            for (int dt = 0; dt < 2; ++dt) { const bf16_t* vp = Vt + (32 * dt + r) * 264 + j0 + 32 * kt + 16 * s2 + 4 * hh; const s16x4 v0 = *(const s16x4*)vp, v1 = *(const s16x4*)(vp + 8);
                const bf16x8 vf = __builtin_shufflevector(v0, v1, 0, 1, 2, 3, 4, 5, 6, 7); o[dt] = MFMA32(vf, pb, o[dt]); } }
#pragma unroll
    for (int dt = 0; dt < 2; ++dt)
#pragma unroll
        for (int g4 = 0; g4 < 4; ++g4) *(uint2*)(optr + 32 * dt + 8 * g4 + 4 * hh) = make_uint2(pk2(o[dt][4 * g4], o[dt][4 * g4 + 1]), pk2(o[dt][4 * g4 + 2], o[dt][4 * g4 + 3]));
}
DI void attn_item(const Params& p, int item) {
    extern __shared__ __attribute__((aligned(16))) unsigned char shm[];
    unsigned char* ws = p.ws; const bf16_t* PROJ = (const bf16_t*)(ws + WS_PROJ); bf16_t* MIX = (bf16_t*)p.out;
    const int tid = threadIdx.x, wid = tid >> 6, lane = tid & 63, r = lane & 31;
    if (item < 256) {
        const int kvh = item & 1, blk = (item >> 1) & 63, b = item >> 7; bf16_t* Ks = (bf16_t*)shm; bf16_t* Vt = (bf16_t*)(shm + 256 * 72 * 2);
        for (int idx = tid; idx < 2048; idx += NTHREADS) { const int key = idx >> 3, d8 = (idx & 7) * 8; const int pos = blk * 128 - 128 + key; uint4 kv = make_uint4(0, 0, 0, 0), vv = make_uint4(0, 0, 0, 0);
            if (pos >= 0) { const bf16_t* src = PROJ + (size_t)(b * 8192 + pos) * 2560 + 512 + kvh * 64 + d8; kv = *(const uint4*)src; vv = *(const uint4*)(src + 128); }
            *(uint4*)(Ks + key * 72 + d8) = kv; bf16_t* vt = Vt + d8 * 264 + key;
            vt[0] = (bf16_t)(vv.x & 0xffff); vt[264] = (bf16_t)(vv.x >> 16); vt[2 * 264] = (bf16_t)(vv.y & 0xffff); vt[3 * 264] = (bf16_t)(vv.y >> 16);
            vt[4 * 264] = (bf16_t)(vv.z & 0xffff); vt[5 * 264] = (bf16_t)(vv.z >> 16); vt[6 * 264] = (bf16_t)(vv.w & 0xffff); vt[7 * 264] = (bf16_t)(vv.w >> 16); }
        __syncthreads();
#pragma unroll 1
        for (int it = 0; it < 2; ++it) { const int ti = wid * 2 + it, g = ti >> 2, qs = (ti & 3) * 32; const int head = kvh * 4 + g; const int m = b * 8192 + blk * 128 + qs + r;
            int lo = qs + r + 1; if (blk == 0 && lo < 128) lo = 128;
            attn_wave_tile(Ks, Vt, qs, PROJ + (size_t)m * 2560 + head * 64, lo, qs + r + 128, p.in[I_SINK][head], MIX + (size_t)m * 1024 + head * 64); }
        __syncthreads();
    } else {
        const int b = item - 256; bf16_t* Ks = (bf16_t*)shm; bf16_t* Vt = (bf16_t*)(shm + 320 * 72 * 2);
        for (int idx = tid; idx < 2 * 160 * 8; idx += NTHREADS) { const int kvh = idx / 1280, rem = idx % 1280, key = rem >> 3, d8 = (rem & 7) * 8; uint4 kv = make_uint4(0, 0, 0, 0), vv = make_uint4(0, 0, 0, 0);
            if (key < 128) { const size_t o = ((size_t)(b * 128 + key) * 2 + kvh) * 64 + d8; const float4 k0 = *(const float4*)(p.in[I_CK] + o), k1 = *(const float4*)(p.in[I_CK] + o + 4), v0 = *(const float4*)(p.in[I_CV] + o), v1 = *(const float4*)(p.in[I_CV] + o + 4);
                kv = make_uint4(pk2(k0.x, k0.y), pk2(k0.z, k0.w), pk2(k1.x, k1.y), pk2(k1.z, k1.w)); vv = make_uint4(pk2(v0.x, v0.y), pk2(v0.z, v0.w), pk2(v1.x, v1.y), pk2(v1.z, v1.w)); }
            else if (key < 136) { const bf16_t* src = PROJ + (size_t)(NP + b * 8 + key - 128) * 2560 + 512 + kvh * 64 + d8; kv = *(const uint4*)src; vv = *(const uint4*)(src + 128); }
            *(uint4*)(Ks + (kvh * 160 + key) * 72 + d8) = kv; bf16_t* vt = Vt + (kvh * 64 + d8) * 264 + key;
            vt[0] = (bf16_t)(vv.x & 0xffff); vt[264] = (bf16_t)(vv.x >> 16); vt[2 * 264] = (bf16_t)(vv.y & 0xffff); vt[3 * 264] = (bf16_t)(vv.y >> 16);
            vt[4 * 264] = (bf16_t)(vv.z & 0xffff); vt[5 * 264] = (bf16_t)(vv.z >> 16); vt[6 * 264] = (bf16_t)(vv.w & 0xffff); vt[7 * 264] = (bf16_t)(vv.w >> 16); }
        __syncthreads();
        if (wid < 2) { const int kvh = wid, g = r >> 3, t = r & 7, head = kvh * 4 + g, m = NP + b * 8 + t;
            attn_wave_tile(Ks + kvh * 160 * 72, Vt + kvh * 64 * 264, 0, PROJ + (size_t)m * 2560 + head * 64, t + 1, t + 128, p.in[I_SINK][head], MIX + (size_t)m * 1024 + head * 64); }
        __syncthreads();
    }
}

DI void phase_scan(const Params& p) {
    extern __shared__ __attribute__((aligned(16))) unsigned char shm[];
    unsigned char* ws = p.ws; const int tid = threadIdx.x, wid = tid >> 6, lane = tid & 63;
    bf16_t* Rb = (bf16_t*)(ws + WS_R); const bf16_t* Kb = (const bf16_t*)(ws + WS_K); const bf16_t* Vb = (const bf16_t*)(ws + WS_V); const bf16_t* Ab = (const bf16_t*)(ws + WS_A); const bf16_t* Bb = (const bf16_t*)(ws + WS_B);
    const float* Wf = (const float*)(ws + WS_W); float* L = (float*)shm + wid * 2560;
    for (int item = wid * gridDim.x + blockIdx.x; item < 1040; item += 8 * gridDim.x) {
        int m0, T, h; float* sout; float S[64];
        if (item < 16) { const int b = item >> 3; h = item & 7; m0 = b * 8192; T = 8192; sout = p.out + O_SP + ((size_t)(b * 8 + h) * 64 + lane) * 64;
#pragma unroll
            for (int k = 0; k < 64; ++k) S[k] = 0.f; }
        else { const int s = item - 16, b = s >> 3; h = s & 7; m0 = NP + b * 8; T = 8; sout = p.out + O_SS + ((size_t)(b * 8 + h) * 64 + lane) * 64; const float* sin = p.in[I_SW] + ((size_t)(b * 8 + h) * 64 + lane) * 64;
#pragma unroll
            for (int k4 = 0; k4 < 16; ++k4) { const float4 v = *(const float4*)(sin + 4 * k4); S[4 * k4] = v.x; S[4 * k4 + 1] = v.y; S[4 * k4 + 2] = v.z; S[4 * k4 + 3] = v.w; } }
#pragma unroll 1
        for (int t0 = 0; t0 < T; t0 += 8) {
            { const int st = lane >> 3, c8 = (lane & 7) * 8; const size_t o = (size_t)(m0 + t0 + st) * 512 + h * 64 + c8; float* l = L + st * 320 + c8;
                const uint4 ur = *(const uint4*)(Rb + o), uk = *(const uint4*)(Kb + o), ua = *(const uint4*)(Ab + o), ub = *(const uint4*)(Bb + o); const float4 w0 = *(const float4*)(Wf + o), w1 = *(const float4*)(Wf + o + 4);
                *(float4*)(l) = make_float4(bflo(ua.x), bfhi(ua.x), bflo(ua.y), bfhi(ua.y)); *(float4*)(l + 4) = make_float4(bflo(ua.z), bfhi(ua.z), bflo(ua.w), bfhi(ua.w));
                *(float4*)(l + 64) = w0; *(float4*)(l + 68) = w1;
                *(float4*)(l + 128) = make_float4(bflo(ub.x), bfhi(ub.x), bflo(ub.y), bfhi(ub.y)); *(float4*)(l + 132) = make_float4(bflo(ub.z), bfhi(ub.z), bflo(ub.w), bfhi(ub.w));
                *(float4*)(l + 192) = make_float4(bflo(uk.x), bfhi(uk.x), bflo(uk.y), bfhi(uk.y)); *(float4*)(l + 196) = make_float4(bflo(uk.z), bfhi(uk.z), bflo(uk.w), bfhi(uk.w));
                *(float4*)(l + 256) = make_float4(bflo(ur.x), bfhi(ur.x), bflo(ur.y), bfhi(ur.y)); *(float4*)(l + 260) = make_float4(bflo(ur.z), bfhi(ur.z), bflo(ur.w), bfhi(ur.w)); }
            float vv[8];
#pragma unroll
            for (int j = 0; j < 8; ++j) vv[j] = bf1(Vb[(size_t)(m0 + t0 + j) * 512 + h * 64 + lane]);
            __builtin_amdgcn_fence(__ATOMIC_RELEASE, "wavefront"); __builtin_amdgcn_wave_barrier(); __builtin_amdgcn_fence(__ATOMIC_ACQUIRE, "wavefront");
#pragma unroll 1
            for (int j = 0; j < 8; ++j) { const float* l = L + j * 320; float sa = 0.f;
#pragma unroll
                for (int k4 = 0; k4 < 16; ++k4) { const float4 a = *(const float4*)(l + 4 * k4); sa += S[4 * k4] * a.x + S[4 * k4 + 1] * a.y + S[4 * k4 + 2] * a.z + S[4 * k4 + 3] * a.w; }
                float vj = vv[0];
#pragma unroll
                for (int q = 1; q < 8; ++q) vj = (j == q) ? vv[q] : vj;
                float o = 0.f;
#pragma unroll
                for (int k4 = 0; k4 < 16; ++k4) { const float4 w = *(const float4*)(l + 64 + 4 * k4), bq = *(const float4*)(l + 128 + 4 * k4), kq = *(const float4*)(l + 192 + 4 * k4), rq = *(const float4*)(l + 256 + 4 * k4);
                    S[4 * k4] = S[4 * k4] * w.x + sa * bq.x + vj * kq.x; S[4 * k4 + 1] = S[4 * k4 + 1] * w.y + sa * bq.y + vj * kq.y; S[4 * k4 + 2] = S[4 * k4 + 2] * w.z + sa * bq.z + vj * kq.z; S[4 * k4 + 3] = S[4 * k4 + 3] * w.w + sa * bq.w + vj * kq.w;
                    o += S[4 * k4] * rq.x + S[4 * k4 + 1] * rq.y + S[4 * k4 + 2] * rq.z + S[4 * k4 + 3] * rq.w; }
                Rb[(size_t)(m0 + t0 + j) * 512 + h * 64 + lane] = (bf16_t)(pk2(o, 0.f) & 0xffff); }
            __builtin_amdgcn_fence(__ATOMIC_RELEASE, "wavefront"); __builtin_amdgcn_wave_barrier(); __builtin_amdgcn_fence(__ATOMIC_ACQUIRE, "wavefront");
        }
#pragma unroll
        for (int k4 = 0; k4 < 16; ++k4) *(float4*)(sout + 4 * k4) = make_float4(S[4 * k4], S[4 * k4 + 1], S[4 * k4 + 2], S[4 * k4 + 3]);
    }
}

DI void phase_post(const Params& p) {
    unsigned char* ws = p.ws; const int tid = threadIdx.x, wid = tid >> 6, lane = tid & 63; bf16_t* MIX = (bf16_t*)p.out;
    const bf16_t* Ob = (const bf16_t*)(ws + WS_R); const bf16_t* Vb = (const bf16_t*)(ws + WS_V); const bf16_t* Gb = (const bf16_t*)(ws + WS_G); const float* BON = (const float*)(ws + WS_BONUS);
    const int h = lane >> 3, c8 = h * 64 + (lane & 7) * 8;
    float gg[8], gb[8];
#pragma unroll
    for (int j = 0; j < 8; ++j) { gg[j] = p.in[I_GNG][c8 + j]; gb[j] = p.in[I_GNB][c8 + j]; }
    for (int m = blockIdx.x * 8 + wid; m < NTOK; m += gridDim.x * 8) { const size_t o = (size_t)m * 512 + c8;
        const uint4 uo = *(const uint4*)(Ob + o), uv = *(const uint4*)(Vb + o), ug = *(const uint4*)(Gb + o); const float bon = BON[(size_t)m * 8 + h];
        float x[8] = {bflo(uo.x), bfhi(uo.x), bflo(uo.y), bfhi(uo.y), bflo(uo.z), bfhi(uo.z), bflo(uo.w), bfhi(uo.w)};
        const float v[8] = {bflo(uv.x), bfhi(uv.x), bflo(uv.y), bfhi(uv.y), bflo(uv.z), bfhi(uv.z), bflo(uv.w), bfhi(uv.w)};
        const float g[8] = {bflo(ug.x), bfhi(ug.x), bflo(ug.y), bfhi(ug.y), bflo(ug.z), bfhi(ug.z), bflo(ug.w), bfhi(ug.w)};
        float s = 0.f;
#pragma unroll
        for (int j = 0; j < 8; ++j) s += x[j];
        s += __shfl_xor(s, 1); s += __shfl_xor(s, 2); s += __shfl_xor(s, 4); const float mean = s * (1.0f / 64.0f); float q = 0.f;
#pragma unroll
        for (int j = 0; j < 8; ++j) { x[j] -= mean; q += x[j] * x[j]; }
        q += __shfl_xor(q, 1); q += __shfl_xor(q, 2); q += __shfl_xor(q, 4); const float rs = rsqrtf(q * (1.0f / 64.0f) + 64e-5f);
        float y[8];
#pragma unroll
        for (int j = 0; j < 8; ++j) y[j] = (x[j] * rs * gg[j] + gb[j] + bon * v[j]) * g[j];
        *(uint4*)(MIX + (size_t)m * 1024 + 512 + c8) = make_uint4(pk2(y[0], y[1]), pk2(y[2], y[3]), pk2(y[4], y[5]), pk2(y[6], y[7])); }
}

DI void phase_final(const Params& p) {
    unsigned char* ws = p.ws; const int tid = threadIdx.x, wid = tid >> 6, lane = tid & 63; const float* X2 = (const float*)(ws + WS_X1); const float* ss = (const float*)(ws + WS_SS2); const float* gf = p.in[I_GFIN];
    float4 g[4];
#pragma unroll
    for (int i = 0; i < 4; ++i) g[i] = *(const float4*)(gf + lane * 4 + 256 * i);
    for (int m = blockIdx.x * 8 + wid; m < NTOK; m += gridDim.x * 8) { const float rstd = rsqrtf(ss[m] * (1.0f / 1024.0f) + 1e-6f);
#pragma unroll
        for (int i = 0; i < 4; ++i) { float4 v = *(const float4*)(X2 + (size_t)m * 1024 + lane * 4 + 256 * i); v.x *= rstd * g[i].x; v.y *= rstd * g[i].y; v.z *= rstd * g[i].z; v.w *= rstd * g[i].w;
            *(float4*)(p.out + O_Y + (size_t)m * 1024 + lane * 4 + 256 * i) = v; } }
}

__global__ void __launch_bounds__(NTHREADS, 2) hymba_fwd(Params p) {
    extern __shared__ __attribute__((aligned(16))) unsigned char shm[];
    cg::grid_group grid = cg::this_grid();
    unsigned char* ws = p.ws; const int G = (int)gridDim.x;
    phase_prep(p);
    grid.sync();
    { pg8::Gemm g{(const bf16_t*)p.out, (const bf16_t*)(ws + WS_WIN), M1, 2560, 1024}; pg8::StaticOrder S; S.init(g.M, g.N, G, (int)blockIdx.x);
      pg8::EpiProj E{(bf16_t*)(ws + WS_PROJ), p.out + O_KWP, p.out + O_VWP, p.out + O_KWS, p.out + O_VWS};
      pg8::gemm_phase<pg8::EpiProj, pg8::StaticOrder, false>((PG8_LAS unsigned char*)shm, g, S, E, nullptr); }
    grid.sync();
    for (int t = blockIdx.x; t < NTOK / 64; t += G) rwkv_prep_tile(p, t);
    for (int it = G - 1 - (int)blockIdx.x; it < 384; it += G) attn_item(p, it);
    grid.sync();
    phase_scan(p);
    grid.sync();
    phase_post(p);
    grid.sync();
    { pg8::Gemm g{(const bf16_t*)p.out, (const bf16_t*)(ws + WS_WOUT), NTOK, 1024, 1024}; pg8::StaticOrder S; S.init(g.M, g.N, G, (int)blockIdx.x);
      pg8::EpiRes<true> E{p.in[I_XP], p.in[I_XS], (float*)(ws + WS_X1), (bf16_t*)(ws + WS_X1B), (float*)(ws + WS_SS1)};
      pg8::gemm_phase<pg8::EpiRes<true>, pg8::StaticOrder, false>((PG8_LAS unsigned char*)shm, g, S, E, nullptr); }
    grid.sync();
    { pg8::Gemm g{(const bf16_t*)(ws + WS_X1B), (const bf16_t*)(ws + WS_WGU), NTOK, 5632, 1024}; pg8::StaticOrder S; S.init(g.M, g.N, G, (int)blockIdx.x);
      pg8::EpiAct E{(bf16_t*)(ws + WS_ACT), (const float*)(ws + WS_SS1)};
      pg8::gemm_phase<pg8::EpiAct, pg8::StaticOrder, false>((PG8_LAS unsigned char*)shm, g, S, E, nullptr); }
    grid.sync();
    { pg8::Gemm g{(const bf16_t*)(ws + WS_ACT), (const bf16_t*)(ws + WS_WD), NTOK, 1024, 2816}; pg8::StaticOrder S; S.init(g.M, g.N, G, (int)blockIdx.x);
      pg8::EpiRes<false> E{(const float*)(ws + WS_X1), nullptr, (float*)(ws + WS_X1), nullptr, (float*)(ws + WS_SS2)};
      pg8::gemm_phase<pg8::EpiRes<false>, pg8::StaticOrder, false>((PG8_LAS unsigned char*)shm, g, S, E, nullptr); }
    grid.sync();
    phase_final(p);
}

extern "C" void kernel_launch(void* const* d_in, const int* in_sizes, int n_in, void* d_out, int out_size, void* d_ws, size_t ws_size, hipStream_t stream) {
    static int grid_blocks = 0;
    if (!grid_blocks) {
        int dev = 0, cus = 0, per_cu = 0;
        (void)hipGetDevice(&dev); (void)hipDeviceGetAttribute(&cus, hipDeviceAttributeMultiprocessorCount, dev);
        (void)hipFuncSetAttribute((const void*)hymba_fwd, hipFuncAttributeMaxDynamicSharedMemorySize, LDS_BYTES);
        (void)hipOccupancyMaxActiveBlocksPerMultiprocessor(&per_cu, (const void*)hymba_fwd, NTHREADS, LDS_BYTES);
        if (per_cu < 1) { fprintf(stderr, "kernel_launch: occupancy query says %d blocks/CU\n", per_cu); per_cu = 1; }
        if (per_cu > 1) per_cu = 1;
        grid_blocks = cus * per_cu;
        (void)hipGetLastError();
    }
    Params p{};
    for (int i = 0; i < 26; ++i) p.in[i] = (const float*)d_in[i];
    p.out = (float*)d_out; p.ws = (unsigned char*)d_ws;
    void* args[] = {&p};
    hipError_t e = hipLaunchCooperativeKernel((const void*)hymba_fwd, dim3(grid_blocks), dim3(NTHREADS), args, LDS_BYTES, stream);
    if (e != hipSuccess) fprintf(stderr, "cooperative launch failed: %s (grid %d)\n", hipGetErrorString(e), grid_blocks);
}
```

```cpp
#include <hip/hip_runtime.h>
#include <hip/hip_cooperative_groups.h>
#include <cstdio>
namespace cg = cooperative_groups;
namespace pg8 {
#define PG8_LAS __attribute__((address_space(3)))
typedef unsigned short bf16_t;
typedef short bf16x8 __attribute__((ext_vector_type(8)));
typedef float f32x4 __attribute__((ext_vector_type(4)));
typedef unsigned u32x4 __attribute__((ext_vector_type(4)));
constexpr int BM = 256, BK = 64, HALF = 128, HTB = HALF * BK * 2  , STAGE_BYTES = 8 * HTB, NXCD = 8, WGM = 8;

__host__ __device__ __forceinline__ int lds_byte(int r, int c) { const int st = (r >> 4) * 2 + (c >> 5), rr = r & 15, cc = c & 31, ob = rr * 64 + cc * 2; return st * 1024 + (ob ^ (((ob >> 9) & 1) << 5)); }
__host__ __device__ __forceinline__ void stage_rc(int b, int& R, int& C) { const int st = b / 1024, sb = b % 1024, swz = sb ^ (((sb >> 9) & 1) << 5); R = (st >> 1) * 16 + swz / 64; C = (st & 1) * 32 + (swz % 64) / 2; }
__host__ __device__ __forceinline__ int perm32(int rho) { const int n = rho >> 4, i = rho & 15; return 8 * (i >> 2) + 4 * n + (i & 3); }

struct Unit { int pm, pn; };
struct Gemm { const bf16_t* A; const bf16_t* Bt; int M, N, K, lda, ldb; };

struct StaticOrder {
    int nM, nN, nwg, G, c;
    __host__ __device__ void init(int M, int N, int G_, int c_) { nM = M / BM; nN = N / BM; nwg = nM * nN; G = G_; c = c_; }
    __host__ __device__ bool next(int i, Unit& u) const {
        const long L = (long)i * G + c; if (L >= nwg) return false;
        int wgid = (int)L; { const int q = nwg / NXCD, r = nwg % NXCD, xcd = wgid % NXCD, off = wgid / NXCD; wgid = (xcd < r ? xcd * (q + 1) : r * (q + 1) + (xcd - r) * q) + off; }
        const int nig = WGM * nN, gid = wgid / nig, fm = gid * WGM, gsz = (nM - fm) < WGM ? (nM - fm) : WGM;
        u.pm = fm + ((wgid % nig) % gsz); u.pn = (wgid % nig) / gsz; return true;
    }
    __device__ __forceinline__ void a_ready(const Unit&) const {}
    __device__ __forceinline__ void done(const Unit&) const {}
};
__device__ __forceinline__ unsigned cvt_pk_bf16(float lo, float hi) { unsigned r; asm volatile("v_cvt_pk_bf16_f32 %0, %1, %2" : "=v"(r) : "v"(lo), "v"(hi)); return r; }
struct EpiProj {
    static constexpr bool PERM = true, AFTER_DRAIN = false;
    bf16_t* O; float* kwp; float* vwp; float* kws; float* vws;
    __device__ __forceinline__ void operator()(const f32x4 (&acc)[2][2][4][2], const Unit& u, int wr, int wc, int fr, int fq) const {
        const int row0 = u.pm * BM + wr * 64 + fr; const int col0 = u.pn * BM + wc * 32 + 8 * fq;
#pragma unroll
        for (int ai = 0; ai < 2; ++ai)
#pragma unroll
            for (int m = 0; m < 4; ++m) { const int row = row0 + ai * HALF + m * 16; bf16_t* rowp = O + (size_t)row * 2560 + col0;
#pragma unroll
                for (int bj = 0; bj < 2; ++bj) { const f32x4 v0 = acc[ai][bj][m][0], v1 = acc[ai][bj][m][1];
                    u32x4 w; w.x = cvt_pk_bf16(v0[0], v0[1]); w.y = cvt_pk_bf16(v0[2], v0[3]); w.z = cvt_pk_bf16(v1[0], v1[1]); w.w = cvt_pk_bf16(v1[2], v1[3]);
                    *(u32x4*)(rowp + bj * HALF) = w; }
                if (u.pn == 2) {
                    int off = -1; bool smp = false;
                    if (row < 16384) { const int t = row & 8191; if (t >= 8064) off = (((row >> 13) * 128) + (t - 8064)) * 128; }
                    else if (row < 17408) { const int s = row - 16384; off = (((s >> 3) * 128) + 120 + (s & 7)) * 128; smp = true; }
                    if (off >= 0) {
#pragma unroll
                        for (int bj = 0; bj < 2; ++bj) { float* d = (smp ? (bj ? vws : kws) : (bj ? vwp : kwp)) + off + wc * 32 + 8 * fq;
                            *(f32x4*)d = acc[ai][bj][m][0]; *(f32x4*)(d + 4) = acc[ai][bj][m][1]; }
                    }
                }
            }
    }
};
template <bool FIRST> struct EpiRes {
    static constexpr bool PERM = false, AFTER_DRAIN = false;
    const float* xin; const float* xin2; float* X; bf16_t* XB; float* ss; int row0_;
    __device__ __forceinline__ void operator()(const f32x4 (&acc)[2][2][4][2], const Unit& u, int wr, int wc, int fr, int fq) const {
        const int row0 = row0_ + u.pm * BM + wr * 64 + fr, col0 = u.pn * BM + wc * 32 + 4 * fq;
#pragma unroll
        for (int ai = 0; ai < 2; ++ai)
#pragma unroll
            for (int m = 0; m < 4; ++m) { const int row = row0 + ai * HALF + m * 16;
                if (FIRST) { const float* xr = row < 16384 ? xin + (size_t)row * 1024 : xin2 + (size_t)(row - 16384) * 1024; float sq = 0.f;
#pragma unroll
                    for (int bj = 0; bj < 2; ++bj)
#pragma unroll
                        for (int n = 0; n < 2; ++n) { const int c = col0 + bj * HALF + n * 16; const f32x4 v = acc[ai][bj][m][n] + *(const f32x4*)(xr + c); sq += v[0] * v[0] + v[1] * v[1] + v[2] * v[2] + v[3] * v[3];
                            uint2 w; w.x = cvt_pk_bf16(v[0], v[1]); w.y = cvt_pk_bf16(v[2], v[3]); *(uint2*)(XB + (size_t)row * 1024 + c) = w; }
                    sq += __shfl_xor(sq, 16); sq += __shfl_xor(sq, 32); if (fq == 0) atomicAdd(ss + row, sq); }
                else {
#pragma unroll
                    for (int bj = 0; bj < 2; ++bj)
#pragma unroll
                        for (int n = 0; n < 2; ++n) { const int c = col0 + bj * HALF + n * 16; const uint2 xb = *(const uint2*)(XB + (size_t)row * 1024 + c);
                            f32x4 v = acc[ai][bj][m][n]; v[0] += __uint_as_float(xb.x << 16); v[1] += __uint_as_float(xb.x & 0xffff0000u); v[2] += __uint_as_float(xb.y << 16); v[3] += __uint_as_float(xb.y & 0xffff0000u);
                            uint2 w; w.x = cvt_pk_bf16(v[0], v[1]); w.y = cvt_pk_bf16(v[2], v[3]); *(uint2*)(XB + (size_t)row * 1024 + c) = w; } }
            }
    }
};
struct EpiAct {
    static constexpr bool PERM = true, AFTER_DRAIN = false;
    bf16_t* ACT; const float* ss; int row0_;
    __device__ __forceinline__ void operator()(const f32x4 (&acc)[2][2][4][2], const Unit& u, int wr, int wc, int fr, int fq) const {
        const int row0 = row0_ + u.pm * BM + wr * 64 + fr, col0 = u.pn * 128 + wc * 32 + 8 * fq;
#pragma unroll
        for (int ai = 0; ai < 2; ++ai)
#pragma unroll
            for (int m = 0; m < 4; ++m) { const int row = row0 + ai * HALF + m * 16; const float rstd = rsqrtf(ss[row] * (1.0f / 1024.0f) + 1e-6f);
                float a[8];
#pragma unroll
                for (int n = 0; n < 2; ++n)
#pragma unroll
                    for (int j = 0; j < 4; ++j) { const float g = acc[ai][0][m][n][j] * rstd, up = acc[ai][1][m][n][j] * rstd; a[4 * n + j] = g * __builtin_amdgcn_rcpf(1.0f + __expf(-g)) * up; }
                u32x4 w; w.x = cvt_pk_bf16(a[0], a[1]); w.y = cvt_pk_bf16(a[2], a[3]); w.z = cvt_pk_bf16(a[4], a[5]); w.w = cvt_pk_bf16(a[6], a[7]);
                *(u32x4*)(ACT + (size_t)row * 2816 + col0) = w; }
    }
};
struct EpiPart {
    static constexpr bool PERM = false, AFTER_DRAIN = false;
    float* P;
    __device__ __forceinline__ void operator()(const f32x4 (&acc)[2][2][4][2], const Unit& u, int wr, int wc, int fr, int fq) const {
        const int row0 = u.pm * BM + wr * 64 + fr, col0 = u.pn * BM + wc * 32 + 4 * fq;
#pragma unroll
        for (int ai = 0; ai < 2; ++ai)
#pragma unroll
            for (int m = 0; m < 4; ++m) { float* rowp = P + (size_t)(row0 + ai * HALF + m * 16) * 1024 + col0;
#pragma unroll
                for (int bj = 0; bj < 2; ++bj)
#pragma unroll
                    for (int n = 0; n < 2; ++n) *(f32x4*)(rowp + bj * HALF + n * 16) = acc[ai][bj][m][n]; }
    }
};

template <class Epi, class Sched, bool STAMP = false>
__device__ __forceinline__ void gemm_phase(PG8_LAS unsigned char* lds, const Gemm g, const Sched& S, const Epi& E, unsigned long long* stamps) {
    const int tid = threadIdx.x, wid = __builtin_amdgcn_readfirstlane(tid >> 6), lane = tid & 63, wr = wid >> 2, wc = wid & 3, fr = lane & 15, fq = lane >> 4;
    const int K = g.K, nt = K / BK;
    int ts_lo = 0, ts_hi = 0, nts = 0; const unsigned long long rt_entry = STAMP ? (unsigned long long)wall_clock64() : 0ull;
#define PG8_STAMP() do { if (STAMP && wid == 0 && nts < 64) { const unsigned long long _c = (unsigned long long)clock64(); \
        ts_lo = (lane == nts) ? (int)(unsigned)_c : ts_lo; ts_hi = (lane == nts) ? (int)(unsigned)(_c >> 32) : ts_hi; ++nts; } } while (0)
    PG8_STAMP();
    unsigned voffA[2], voffB[2];
#pragma unroll
    for (int i = 0; i < 2; ++i) { int R, C; stage_rc(tid * 16 + i * 8192, R, C); const int Rb = Epi::PERM ? ((R & ~31) + perm32(R & 31)) : R;
        voffA[i] = (unsigned)(R * g.lda + C) * 2u; voffB[i] = (unsigned)(Rb * g.ldb + C) * 2u; }
    const size_t kstep = (size_t)(BK * 2);
    const size_t hstepA = (size_t)HALF * g.lda * 2, hstepB = (size_t)HALF * g.ldb * 2;
    const size_t tstepA = 2 * hstepA, tstepB = 2 * hstepB;
    const unsigned ldsw = (unsigned)wid * 1024u;
    const int aoff = lds_byte(wr * 64 + fr, fq * 8), boff = lds_byte(wc * 32 + fr, fq * 8);
#define PG8_SA(b, h) (((b) * 2 + (h)) * HTB)
#define PG8_SB(b, h) ((4 + (b) * 2 + (h)) * HTB)
#define PG8_STAGE(bufoff, gbase, voff) do { _Pragma("unroll") for (int _i = 0; _i < 2; ++_i) \
        __builtin_amdgcn_global_load_lds((const unsigned*)((const char*)(gbase) + (voff)[_i]), (PG8_LAS unsigned*)(lds + (bufoff) + ldsw + _i * 8192), 16, 0, 0); } while (0)
#define PG8_LDA(dst, b, h) do { _Pragma("unroll") for (int m = 0; m < 4; ++m) _Pragma("unroll") for (int k = 0; k < 2; ++k) dst[m][k] = *(const PG8_LAS bf16x8*)(lds + PG8_SA(b, h) + aoff + m * 2048 + k * 1024); } while (0)
#define PG8_LDB(dst, b, h) do { _Pragma("unroll") for (int n = 0; n < 2; ++n) _Pragma("unroll") for (int k = 0; k < 2; ++k) dst[n][k] = *(const PG8_LAS bf16x8*)(lds + PG8_SB(b, h) + boff + n * 2048 + k * 1024); } while (0)
#define PG8_MMA(ai, bj, At, Bt) do { __builtin_amdgcn_s_setprio(1); _Pragma("unroll") for (int m = 0; m < 4; ++m) _Pragma("unroll") for (int n = 0; n < 2; ++n) _Pragma("unroll") for (int k = 0; k < 2; ++k) \
        acc[ai][bj][m][n] = __builtin_amdgcn_mfma_f32_16x16x32_bf16(Bt[n][k], At[m][k], acc[ai][bj][m][n], 0, 0, 0); __builtin_amdgcn_s_setprio(0); } while (0)
#define PG8_WAIT_V(n) asm volatile("s_waitcnt vmcnt(" #n ")" ::: "memory")
#define PG8_WAIT_L(n) asm volatile("s_waitcnt lgkmcnt(" #n ")" ::: "memory")
#define PG8_BAR __builtin_amdgcn_s_barrier()
#define PG8_SCHED __builtin_amdgcn_sched_barrier(0)
    Unit cur, nxt; int ui = 0;
    if (!S.next(0, cur)) return;
    f32x4 acc[2][2][4][2];
#pragma unroll
    for (int a = 0; a < 2; ++a)
#pragma unroll
        for (int b = 0; b < 2; ++b)
#pragma unroll
            for (int m = 0; m < 4; ++m)
#pragma unroll
                for (int n = 0; n < 2; ++n) acc[a][b][m][n] = (f32x4){0.f, 0.f, 0.f, 0.f};
    bf16x8 At[4][2], B0[2][2], B1[2][2];
    const char* cA = (const char*)g.A + (size_t)cur.pm * tstepA; const char* cB = (const char*)g.Bt + (size_t)cur.pn * tstepB;
    S.a_ready(cur);
    PG8_STAGE(PG8_SB(0, 0), cB, voffB); PG8_STAGE(PG8_SA(0, 0), cA, voffA); PG8_STAGE(PG8_SB(0, 1), cB + hstepB, voffB); PG8_STAGE(PG8_SA(0, 1), cA + hstepA, voffA);
    if (wr == 1) PG8_BAR;
    PG8_WAIT_V(4); PG8_BAR;
    PG8_STAGE(PG8_SB(1, 0), cB + kstep, voffB); PG8_STAGE(PG8_SA(1, 0), cA + kstep, voffA); PG8_STAGE(PG8_SB(1, 1), cB + hstepB + kstep, voffB);
    PG8_WAIT_V(6); PG8_BAR;
    PG8_STAMP();
    for (;;) {
        const bool has_next = S.next(ui + 1, nxt);
        const char* nA = has_next ? (const char*)g.A + (size_t)nxt.pm * tstepA : cA; const char* nB = has_next ? (const char*)g.Bt + (size_t)nxt.pn * tstepB : cB;
        for (int t = 0; t < nt; t += 2) {
            const bool last = (t == nt - 2);
            const char* a1 = cA + (size_t)(t + 1) * kstep;
            const char* a2 = last ? nA : cA + (size_t)(t + 2) * kstep; const char* b2 = last ? nB : cB + (size_t)(t + 2) * kstep;
            const char* a3 = a2 + kstep; const char* b3 = b2 + kstep;
            if (last && has_next) S.a_ready(nxt);
            PG8_LDB(B0, 0, 0); PG8_SCHED; PG8_LDA(At, 0, 0); PG8_STAGE(PG8_SA(1, 1), a1 + hstepA, voffA);
            PG8_WAIT_L(8); PG8_BAR; PG8_WAIT_L(0); PG8_MMA(0, 0, At, B0); PG8_BAR; PG8_SCHED;
            PG8_LDB(B1, 0, 1); PG8_STAGE(PG8_SB(0, 0), b2, voffB);
            PG8_BAR; PG8_WAIT_L(0); PG8_MMA(0, 1, At, B1); PG8_BAR;
            PG8_LDA(At, 0, 1); PG8_STAGE(PG8_SA(0, 0), a2, voffA);
            PG8_BAR; PG8_WAIT_L(0); PG8_MMA(1, 0, At, B0); PG8_BAR; PG8_SCHED;
            PG8_STAGE(PG8_SB(0, 1), b2 + hstepB, voffB);
            PG8_WAIT_V(6); PG8_BAR; PG8_MMA(1, 1, At, B1); PG8_BAR;
            PG8_LDB(B0, 1, 0); PG8_SCHED; PG8_LDA(At, 1, 0); PG8_STAGE(PG8_SA(0, 1), a2 + hstepA, voffA);
            PG8_WAIT_L(8); PG8_BAR; PG8_WAIT_L(0); PG8_MMA(0, 0, At, B0); PG8_BAR; PG8_SCHED;
            PG8_LDB(B1, 1, 1); PG8_STAGE(PG8_SB(1, 0), b3, voffB);
            PG8_BAR; PG8_WAIT_L(0); PG8_MMA(0, 1, At, B1); PG8_BAR;
            PG8_LDA(At, 1, 1); PG8_STAGE(PG8_SA(1, 0), a3, voffA);
            PG8_BAR; PG8_WAIT_L(0); PG8_MMA(1, 0, At, B0); PG8_BAR; PG8_SCHED;
            PG8_STAGE(PG8_SB(1, 1), b3 + hstepB, voffB);
            PG8_WAIT_V(6); PG8_BAR; PG8_MMA(1, 1, At, B1); PG8_BAR;
        }
        PG8_STAMP();
        if constexpr (!Epi::AFTER_DRAIN) { E(acc, cur, wr, wc, fr, fq); S.done(cur); }
        PG8_STAMP();
        if (!has_next) break;
#pragma unroll
        for (int a = 0; a < 2; ++a)
#pragma unroll
            for (int b = 0; b < 2; ++b)
#pragma unroll
                for (int m = 0; m < 4; ++m)
#pragma unroll
                    for (int n = 0; n < 2; ++n) acc[a][b][m][n] = (f32x4){0.f, 0.f, 0.f, 0.f};
        cur = nxt; cA = nA; cB = nB; ++ui;
    }
    PG8_WAIT_V(0);
    if (wr == 0) PG8_BAR;
    PG8_BAR;
    if constexpr (Epi::AFTER_DRAIN) { E.fused(acc, cur, wr, wc, fr, fq, lds, wid, lane); S.done(cur); }
    PG8_STAMP();
    if (STAMP && wid == 0) { stamps[lane] = lane < nts ? (((unsigned long long)(unsigned)ts_hi << 32) | (unsigned)ts_lo) : 0ull;
        if (lane == 62) stamps[62] = rt_entry; if (lane == 63) stamps[63] = (unsigned long long)wall_clock64(); }
#undef PG8_STAMP
#undef PG8_SA
#undef PG8_SB
#undef PG8_STAGE
#undef PG8_LDA
#undef PG8_LDB
#undef PG8_MMA
#undef PG8_WAIT_V
#undef PG8_WAIT_L
#undef PG8_BAR
#undef PG8_SCHED
}
}
#define DI __device__ __forceinline__
typedef unsigned short bf16_t;
typedef short bf16x8 __attribute__((ext_vector_type(8)));
typedef short s16x4 __attribute__((ext_vector_type(4)));
typedef float f32x4 __attribute__((ext_vector_type(4)));
typedef float f32x16 __attribute__((ext_vector_type(16)));
typedef unsigned u32x4 __attribute__((ext_vector_type(4)));
typedef float f32x2v __attribute__((ext_vector_type(2)));
typedef __bf16 bf2v __attribute__((ext_vector_type(2)));
#define MFMA32(a, b, c) __builtin_amdgcn_mfma_f32_32x32x16_bf16((a), (b), (c), 0, 0, 0)
#define MFMA16(a, b, c) __builtin_amdgcn_mfma_f32_16x16x32_bf16((a), (b), (c), 0, 0, 0)

constexpr int NP = 16384, NTOK = 17408, M1 = 17664, LDS_BYTES = 147456, NTHREADS = 512;
constexpr size_t WS_WIN = 0, WS_WOUT = 5242880, WS_WGU = 7340032, WS_WD = 18874368, WS_W2T = 24641536, WS_A2T = WS_W2T + 65536, WS_G2T = WS_A2T + 65536,
    WS_SS1 = 24903680, WS_SS2 = WS_SS1 + 69632, WS_BONUS = 25042944, WS_PROJ = 25600000, WS_RW = 116039680, RWB = 17825792  ,
    WS_R = WS_RW, WS_K = WS_RW + RWB, WS_V = WS_RW + 2 * RWB, WS_A = WS_RW + 3 * RWB, WS_B = WS_RW + 4 * RWB, WS_G = WS_RW + 5 * RWB, WS_W = WS_RW + 6 * RWB,
    WS_MT = WS_PROJ, WS_N = WS_PROJ + 16777216, WS_QT = WS_PROJ + 50331648, WS_SC = WS_PROJ + 67108864,
    WS_PART = 230596608, WS_BAR = 258646016,
    WS_X1 = 25600000, WS_X1B = 96903168, WS_ACT = 132554752;
constexpr size_t O_Y = 0, O_KWP = 17825792, O_VWP = O_KWP + 32768, O_SP = O_VWP + 32768, O_HP = O_SP + 65536, O_KWS = O_HP + 2048, O_VWS = O_KWS + 2097152, O_SS = O_VWS + 2097152, O_HS = O_SS + 4194304;

struct Params { const float* in[26]; float* out; unsigned char* ws; };
enum { I_XP = 0, I_XS, I_CK, I_CV, I_SW, I_SH, I_GMIX, I_WIN, I_SINK, I_MU, I_W0, I_W2, I_A0, I_A2, I_G2, I_KK, I_KA, I_RK, I_GNG, I_GNB, I_WOUT, I_GFFN, I_WG, I_WU, I_WD, I_GFIN };

DI int opaque_tid() { int t = threadIdx.x; asm volatile("" : "+v"(t)); return t; }
DI unsigned pk2(float a, float b) { f32x2v v = {a, b}; return __builtin_bit_cast(unsigned, __builtin_convertvector(v, bf2v)); }
DI unsigned pk2a(float lo, float hi) { unsigned r; asm volatile("v_cvt_pk_bf16_f32 %0, %1, %2" : "=v"(r) : "v"(lo), "v"(hi)); return r; }
DI float bflo(unsigned u) { return __uint_as_float(u << 16); }
DI float bfhi(unsigned u) { return __uint_as_float(u & 0xffff0000u); }
DI float bf1(bf16_t u) { return __uint_as_float(((unsigned)u) << 16); }
DI float sigmoidf_(float x) { return __builtin_amdgcn_rcpf(1.0f + __expf(-x)); }
DI float tanhf_(float x) { return 1.0f - 2.0f * __builtin_amdgcn_rcpf(1.0f + __expf(2.0f * x)); }
DI int prev_row(int m) {
    if (m < NP) return (m & 8191) == 0 ? -1 : m - 1;
    const int s = m - NP; return (s & 7) == 0 ? NTOK + (s >> 3) : m - 1;
}

#define LBAR0() do { asm volatile("s_waitcnt lgkmcnt(0)" ::: "memory"); __builtin_amdgcn_s_barrier(); asm volatile("" ::: "memory"); } while (0)
struct TrJob { const float* src; bf16_t* dst; const float* scale; int ldn, k0, n0, ldk, drow0; };
DI TrJob tr_decode(const Params& p, int job) {
    unsigned char* ws = p.ws; int j = job; TrJob t;
    if (j < 640) { t = TrJob{p.in[I_WIN], (bf16_t*)(ws + WS_WIN), nullptr, 2560, (j % 16) * 64, (j / 16) * 64, 1024, (j / 16) * 64}; return t; } j -= 640;
    if (j < 256) { t = TrJob{p.in[I_WOUT], (bf16_t*)(ws + WS_WOUT), nullptr, 1024, (j % 16) * 64, (j / 16) * 64, 1024, (j / 16) * 64}; return t; } j -= 256;
    if (j < 1408) { const bool up = j >= 704; if (up) j -= 704; const int n0 = (j / 16) * 64; const int dr = (n0 >> 7) * 256 + (up ? 128 : 0) + (n0 & 127);
        t = TrJob{p.in[up ? I_WU : I_WG], (bf16_t*)(ws + WS_WGU), p.in[I_GFFN], 2816, (j % 16) * 64, n0, 1024, dr}; return t; } j -= 1408;
    if (j < 704) { t = TrJob{p.in[I_WD], (bf16_t*)(ws + WS_WD), nullptr, 1024, (j % 44) * 64, (j / 44) * 64, 2816, (j / 44) * 64}; return t; } j -= 704;
    if (j < 8) { t = TrJob{p.in[I_W2], (bf16_t*)(ws + WS_W2T), nullptr, 512, 0, j * 64, 64, j * 64}; return t; } j -= 8;
    if (j < 8) { t = TrJob{p.in[I_A2], (bf16_t*)(ws + WS_A2T), nullptr, 512, 0, j * 64, 64, j * 64}; return t; } j -= 8;
    t = TrJob{p.in[I_G2], (bf16_t*)(ws + WS_G2T), nullptr, 512, (j & 1) * 64, (j >> 1) * 64, 128, (j >> 1) * 64}; return t;
}
DI void tr_load(const TrJob& t, float4& a, float4& b, float& sc) { const int tid = opaque_tid(), r = tid >> 3, c8 = (tid & 7) * 8; const float* s = t.src + (size_t)(t.k0 + r) * t.ldn + t.n0 + c8;
    a = *(const float4*)s; b = *(const float4*)(s + 4); sc = t.scale ? t.scale[t.k0 + r] : 1.f; }
DI void tr_finish(const TrJob& t, const float4& a, const float4& b, float sc) {
    extern __shared__ __attribute__((aligned(16))) unsigned char shm[]; float* T = (float*)shm;
    const int tid = opaque_tid(); { const int r = tid >> 3, c8 = (tid & 7) * 8; float* q = T + r * 65 + c8;
        q[0] = a.x * sc; q[1] = a.y * sc; q[2] = a.z * sc; q[3] = a.w * sc; q[4] = b.x * sc; q[5] = b.y * sc; q[6] = b.z * sc; q[7] = b.w * sc; }
    LBAR0();
    { const int n = tid >> 3, k8 = (tid & 7) * 8; float v[8];
#pragma unroll
        for (int j = 0; j < 8; ++j) v[j] = T[(k8 + j) * 65 + n];
        uint4 w; w.x = pk2(v[0], v[1]); w.y = pk2(v[2], v[3]); w.z = pk2(v[4], v[5]); w.w = pk2(v[6], v[7]);
        *(uint4*)(t.dst + (size_t)(t.drow0 + n) * t.ldk + t.k0 + k8) = w; }
    LBAR0();
}
DI void tr_run(const Params& p, int first, int stride, int lo, int n) {
    auto jobof = [&](int v) -> int { return lo == 0 ? (v < 640 ? v : 3008 + (v - 640)) : lo + v; };
    int v = first; if (v >= n) return; TrJob cur = tr_decode(p, jobof(v)); float4 a, b; float sc; tr_load(cur, a, b, sc);
#pragma unroll 1
    for (; v < n; v += stride) { const int nv = v + stride; const TrJob nxt = tr_decode(p, jobof(nv < n ? nv : v)); float4 a2, b2; float sc2; tr_load(nxt, a2, b2, sc2);
        tr_finish(cur, a, b, sc); cur = nxt; a = a2; b = b2; sc = sc2; }
}
DI void phase_prep(const Params& p) {
    unsigned char* ws = p.ws; const int tid = opaque_tid(), wid = tid >> 6, lane = tid & 63;
    tr_run(p, blockIdx.x, gridDim.x, 640, 2400);
    tr_run(p, blockIdx.x, gridDim.x, 0, 640);
    bf16_t* XN = (bf16_t*)p.out; const float* gm = p.in[I_GMIX];
    auto rowsrc = [&](int m) -> const float* { return m < NP ? p.in[I_XP] + (size_t)m * 1024 : (m < NTOK ? p.in[I_XS] + (size_t)(m - NP) * 1024 : p.in[I_SH] + (size_t)(m < NTOK + 128 ? m - NTOK : 0) * 1024); };
    { int m = blockIdx.x * 8 + wid; float4 v[4];
      if (m < M1) { const float* src = rowsrc(m);
#pragma unroll
          for (int i = 0; i < 4; ++i) v[i] = *(const float4*)(src + lane * 4 + 256 * i); }
#pragma unroll 1
      for (; m < M1; m += gridDim.x * 8) {
        bf16_t* dst = XN + (size_t)m * 1024; const int mn = m + gridDim.x * 8; float4 vn[4];
        if (mn < M1) { const float* src = rowsrc(mn);
#pragma unroll
            for (int i = 0; i < 4; ++i) vn[i] = *(const float4*)(src + lane * 4 + 256 * i); }
        if (m >= NTOK + 128) { for (int i = 0; i < 4; ++i) *(uint2*)(dst + lane * 4 + 256 * i) = make_uint2(0u, 0u); }
        else {
        float sq = 0.f;
#pragma unroll
        for (int i = 0; i < 4; ++i) sq += v[i].x * v[i].x + v[i].y * v[i].y + v[i].z * v[i].z + v[i].w * v[i].w;
        float rstd = 1.f; const bool norm = m < NTOK;
        if (norm) {
#pragma unroll
            for (int o = 32; o >= 1; o >>= 1) sq += __shfl_xor(sq, o);
            rstd = rsqrtf(sq * (1.0f / 1024.0f) + 1e-6f); }
        float* sh = nullptr;
        if (m < NP) { if ((m & 8191) == 8191) sh = p.out + O_HP + (size_t)(m >> 13) * 1024; } else if (m < NTOK) { const int s = m - NP; if ((s & 7) == 7) sh = p.out + O_HS + (size_t)(s >> 3) * 1024; }
#pragma unroll
        for (int i = 0; i < 4; ++i) { float4 h = v[i];
            if (norm) { const float4 g = *(const float4*)(gm + lane * 4 + 256 * i); h.x *= rstd * g.x; h.y *= rstd * g.y; h.z *= rstd * g.z; h.w *= rstd * g.w; }
            *(uint2*)(dst + lane * 4 + 256 * i) = make_uint2(pk2(h.x, h.y), pk2(h.z, h.w));
            if (sh) *(float4*)(sh + lane * 4 + 256 * i) = h; }
        }
#pragma unroll
        for (int i = 0; i < 4; ++i) v[i] = vn[i];
      } }
    const size_t gt = (size_t)blockIdx.x * NTHREADS + tid, gs = (size_t)gridDim.x * NTHREADS;
    for (int i = (int)gt; i < 2 * 128 * 3840; i += (int)gs) { const int which = i >= 128 * 3840 ? 1 : 0; const int rr = i - which * 128 * 3840; const int b = rr / 3840, q = rr - b * 3840;
        const float* s = p.in[which ? I_CV : I_CK] + (size_t)b * 16384 + 1024 + q * 4; float* d = p.out + (which ? O_VWS : O_KWS) + (size_t)b * 16384 + q * 4; *(float4*)d = *(const float4*)s; }
    for (size_t i = gt; i < (size_t)NTOK; i += gs) ((float*)(ws + WS_SS1))[i] = 0.f;
}

DI void load4bf(const bf16_t* p_, float (&o)[4]) { const uint2 u = *(const uint2*)p_; o[0] = bflo(u.x); o[1] = bfhi(u.x); o[2] = bflo(u.y); o[3] = bfhi(u.y); }
DI void xs4(const bf16_t* cp, const bf16_t* pp, float pf, const float* mu, float (&o)[4]) {
    float c[4], q[4]; load4bf(cp, c); load4bf(pp, q);
    const float4 u = *(const float4*)mu; o[0] = c[0] + (q[0] * pf - c[0]) * u.x; o[1] = c[1] + (q[1] * pf - c[1]) * u.y; o[2] = c[2] + (q[2] * pf - c[2]) * u.z; o[3] = c[3] + (q[3] * pf - c[3]) * u.w;
}
DI void rwkv_prep_unit(const Params& p, int unit) {
    extern __shared__ __attribute__((aligned(16))) unsigned char shm[]; bf16_t* XL = (bf16_t*)shm;
    unsigned char* ws = p.ws; const bf16_t* PROJ = (const bf16_t*)(ws + WS_PROJ); const float* mu = p.in[I_MU];
    const int tid = opaque_tid(), wid = tid >> 6, lane = tid & 63, r = lane & 31, hh = lane >> 5, m0 = unit * 32;
    for (int idx = tid; idx < 32 * 32; idx += NTHREADS) { const int tok = idx >> 5, c8 = (idx & 31) * 8, m = m0 + tok, pr = prev_row(m);
        const bf16_t* cp = PROJ + (size_t)m * 2560 + 768 + 1536 + c8; const bf16_t* pp = PROJ + (size_t)(pr >= 0 ? pr : m) * 2560 + 768 + 1536 + c8; const float pf = pr >= 0 ? 1.f : 0.f;
        float a[4], b[4]; xs4(cp, pp, pf, mu + 1536 + c8, a); xs4(cp + 4, pp + 4, pf, mu + 1536 + c8 + 4, b);
        if (c8 < 64) {
#pragma unroll
            for (int j = 0; j < 4; ++j) { a[j] = tanhf_(a[j]); b[j] = tanhf_(b[j]); } }
        else if (c8 >= 128) {
#pragma unroll
            for (int j = 0; j < 4; ++j) { a[j] = sigmoidf_(a[j]); b[j] = sigmoidf_(b[j]); } }
        uint4 w; w.x = pk2(a[0], a[1]); w.y = pk2(a[2], a[3]); w.z = pk2(b[0], b[1]); w.w = pk2(b[2], b[3]); *(uint4*)(XL + tok * 264 + c8) = w; }
    float* INVN = (float*)(shm + 34048);
#pragma unroll 1
    for (int idx = tid; idx < 32 * 128; idx += NTHREADS) { const int tok = idx >> 7, c4 = (idx & 127) * 4, m = m0 + tok, pr = prev_row(m); const float pf = pr >= 0 ? 1.f : 0.f;
        float k4[4]; xs4(PROJ + (size_t)m * 2560 + 768 + 512 + c4, PROJ + (size_t)(pr >= 0 ? pr : m) * 2560 + 768 + 512 + c4, pf, mu + 512 + c4, k4); const float4 kk4 = *(const float4*)(p.in[I_KK] + c4);
        const float q0 = k4[0] * kk4.x, q1 = k4[1] * kk4.y, q2 = k4[2] * kk4.z, q3 = k4[3] * kk4.w; float sq = q0 * q0 + q1 * q1 + q2 * q2 + q3 * q3;
        sq += __shfl_xor(sq, 1); sq += __shfl_xor(sq, 2); sq += __shfl_xor(sq, 4); sq += __shfl_xor(sq, 8);
        if ((lane & 15) == 0) INVN[tok * 8 + (c4 >> 6)] = rsqrtf(sq + 1e-12f); }
    __syncthreads();
    const int h = wid, c2 = h * 64 + 2 * r; const bf16_t* w2t = (const bf16_t*)(ws + WS_W2T); const bf16_t* a2t = (const bf16_t*)(ws + WS_A2T); const bf16_t* g2t = (const bf16_t*)(ws + WS_G2T);
    bf16_t* Rb = (bf16_t*)(ws + WS_R); bf16_t* Kb = (bf16_t*)(ws + WS_K); bf16_t* Vb = (bf16_t*)(ws + WS_V); bf16_t* Ab = (bf16_t*)(ws + WS_A); bf16_t* Bb = (bf16_t*)(ws + WS_B); bf16_t* Gb = (bf16_t*)(ws + WS_G);
    float* Wf = (float*)(ws + WS_W); float* BON = (float*)(ws + WS_BONUS);
    const float2 mur = *(const float2*)(mu + c2), muk = *(const float2*)(mu + 512 + c2), muv = *(const float2*)(mu + 1024 + c2), kkc = *(const float2*)(p.in[I_KK] + c2), kac = *(const float2*)(p.in[I_KA] + c2),
                 w0c = *(const float2*)(p.in[I_W0] + c2), a0c = *(const float2*)(p.in[I_A0] + c2), rkc = *(const float2*)(p.in[I_RK] + c2);
    { const int tt = 0;
        f32x16 Dw[2], Da[2], Dg[2];
#pragma unroll
        for (int ct = 0; ct < 2; ++ct)
#pragma unroll
            for (int i = 0; i < 16; ++i) { Dw[ct][i] = 0.f; Da[ct][i] = 0.f; Dg[ct][i] = 0.f; }
        const bf16_t* xrow = XL + (32 * tt + r) * 264 + 8 * hh;
        { bf16x8 wf[4][2];
#pragma unroll
            for (int s = 0; s < 4; ++s)
#pragma unroll
                for (int ct = 0; ct < 2; ++ct) wf[s][ct] = *(const bf16x8*)(w2t + (c2 + ct) * 64 + 16 * s + 8 * hh);
#pragma unroll
            for (int s = 0; s < 4; ++s) { const bf16x8 xw = *(const bf16x8*)(xrow + 16 * s);
#pragma unroll
                for (int ct = 0; ct < 2; ++ct) Dw[ct] = MFMA32(xw, wf[s][ct], Dw[ct]); } }
        __builtin_amdgcn_sched_barrier(0);
        { bf16x8 af[4][2];
#pragma unroll
            for (int s = 0; s < 4; ++s)
#pragma unroll
                for (int ct = 0; ct < 2; ++ct) af[s][ct] = *(const bf16x8*)(a2t + (c2 + ct) * 64 + 16 * s + 8 * hh);
#pragma unroll
            for (int s = 0; s < 4; ++s) { const bf16x8 xa = *(const bf16x8*)(xrow + 64 + 16 * s);
#pragma unroll
                for (int ct = 0; ct < 2; ++ct) Da[ct] = MFMA32(xa, af[s][ct], Da[ct]); } }
        __builtin_amdgcn_sched_barrier(0);
#pragma unroll
        for (int sh2 = 0; sh2 < 2; ++sh2) { bf16x8 gf[4][2];
#pragma unroll
            for (int s = 0; s < 4; ++s)
#pragma unroll
                for (int ct = 0; ct < 2; ++ct) gf[s][ct] = *(const bf16x8*)(g2t + (c2 + ct) * 128 + 64 * sh2 + 16 * s + 8 * hh);
#pragma unroll
            for (int s = 0; s < 4; ++s) { const bf16x8 xg = *(const bf16x8*)(xrow + 128 + 64 * sh2 + 16 * s);
#pragma unroll
                for (int ct = 0; ct < 2; ++ct) Dg[ct] = MFMA32(xg, gf[s][ct], Dg[ct]); }
            __builtin_amdgcn_sched_barrier(0); }
#pragma unroll
        for (int i = 0; i < 16; ++i) *(unsigned*)(Gb + (size_t)(m0 + 32 * tt + (i & 3) + 8 * (i >> 2) + 4 * hh) * 512 + c2) = pk2(Dg[0][i], Dg[1][i]);
        __builtin_amdgcn_sched_barrier(0);
        float bon[16];
#pragma unroll
        for (int i = 0; i < 16; ++i) { const int m = m0 + 32 * tt + (i & 3) + 8 * (i >> 2) + 4 * hh, pr = prev_row(m); const float pf = pr >= 0 ? 1.f : 0.f;
            const bf16_t* cp = PROJ + (size_t)m * 2560 + 768 + c2; const bf16_t* pp = PROJ + (size_t)(pr >= 0 ? pr : m) * 2560 + 768 + c2;
            const unsigned urc = *(const unsigned*)cp, ukc = *(const unsigned*)(cp + 512), uvc = *(const unsigned*)(cp + 1024), urp = *(const unsigned*)pp, ukp = *(const unsigned*)(pp + 512), uvp = *(const unsigned*)(pp + 1024);
            const float inv = INVN[(32 * tt + (i & 3) + 8 * (i >> 2) + 4 * hh) * 8 + h];
            float rr[2], kx[2], vx[2], dec[2], km[2], an[2], bn[2];
            { float c; c = bflo(urc); rr[0] = c + (bflo(urp) * pf - c) * mur.x; c = bfhi(urc); rr[1] = c + (bfhi(urp) * pf - c) * mur.y;
              c = bflo(ukc); kx[0] = c + (bflo(ukp) * pf - c) * muk.x; c = bfhi(ukc); kx[1] = c + (bfhi(ukp) * pf - c) * muk.y;
              c = bflo(uvc); vx[0] = c + (bflo(uvp) * pf - c) * muv.x; c = bfhi(uvc); vx[1] = c + (bfhi(uvp) * pf - c) * muv.y; }
            const float kk2[2] = {kkc.x, kkc.y}, ka2[2] = {kac.x, kac.y}, w02[2] = {w0c.x, w0c.y}, a02[2] = {a0c.x, a0c.y}, rk2[2] = {rkc.x, rkc.y};
            float bsum = 0.f;
#pragma unroll
            for (int ct = 0; ct < 2; ++ct) { const float x = -(w02[ct] + Dw[ct][i]); const float sp = fmaxf(x, 0.f) + 0.69314718f * __builtin_amdgcn_logf(1.0f + __expf(-fabsf(x))); dec[ct] = -__expf(-sp - 0.5f);
                const float as = sigmoidf_(a02[ct] + Da[ct][i]); const float kkn = kx[ct] * kk2[ct] * inv; km[ct] = kx[ct] * (1.0f + (as - 1.0f) * ka2[ct]); an[ct] = -kkn; bn[ct] = kkn * as; bsum += rr[ct] * km[ct] * rk2[ct]; }
            bon[i] = bsum; const size_t o = (size_t)m * 512 + c2;
            *(unsigned*)(Rb + o) = pk2(rr[0], rr[1]); *(unsigned*)(Kb + o) = pk2(km[0], km[1]); *(unsigned*)(Vb + o) = pk2(vx[0], vx[1]); *(unsigned*)(Ab + o) = pk2(an[0], an[1]); *(unsigned*)(Bb + o) = pk2(bn[0], bn[1]);
            *(float2*)(Wf + o) = make_float2(dec[0], dec[1]);
            if ((i & 3) == 3) __builtin_amdgcn_sched_barrier(0); }
    #pragma unroll
        for (int o = 1; o < 32; o <<= 1)
#pragma unroll
            for (int i = 0; i < 16; ++i) bon[i] += __shfl_xor(bon[i], o);
        if (r == 0) {
#pragma unroll
            for (int i = 0; i < 16; ++i) BON[(size_t)(m0 + 32 * tt + (i & 3) + 8 * (i >> 2) + 4 * hh) * 8 + h] = bon[i]; }
    }
    __syncthreads();
}

DI void attn_wave_tile(const bf16_t* Ks, const bf16_t* Vt, int j0, const bf16_t* qptr, int lo, int hi, float sink, bf16_t* optr) {
    const int lane = opaque_tid() & 63, r = lane & 31, hh = lane >> 5;
    bf16x8 qf[4];
#pragma unroll
    for (int s = 0; s < 4; ++s) qf[s] = *(const bf16x8*)(qptr + 16 * s + 8 * hh);
    f32x16 sc[5];
#pragma unroll
    for (int kt = 0; kt < 5; ++kt) {
#pragma unroll
        for (int i = 0; i < 16; ++i) sc[kt][i] = 0.f;
#pragma unroll
        for (int s = 0; s < 4; ++s) sc[kt] = MFMA32(*(const bf16x8*)(Ks + (j0 + 32 * kt + r) * 72 + 16 * s + 8 * hh), qf[s], sc[kt]); }
    float mx = sink;
#pragma unroll
    for (int kt = 0; kt < 5; ++kt)
#pragma unroll
        for (int i = 0; i < 16; ++i) { const int j = j0 + 32 * kt + (i & 3) + 8 * (i >> 2) + 4 * hh; const bool ok = (j >= lo) && (j <= hi); const float s = ok ? sc[kt][i] * 0.125f : -1e30f; sc[kt][i] = s; mx = fmaxf(mx, s); }
    mx = fmaxf(mx, __shfl_xor(mx, 32));
    float sum = 0.f;
#pragma unroll
    for (int kt = 0; kt < 5; ++kt)
#pragma unroll
        for (int i = 0; i < 16; ++i) { const float e = __expf(sc[kt][i] - mx); sc[kt][i] = e; sum += e; }
    sum += __shfl_xor(sum, 32); sum += __expf(sink - mx); const float inv = 1.0f / sum;
    f32x16 o[2];
#pragma unroll
    for (int i = 0; i < 16; ++i) { o[0][i] = 0.f; o[1][i] = 0.f; }
#pragma unroll
    for (int kt = 0; kt < 5; ++kt)
#pragma unroll
        for (int s2 = 0; s2 < 2; ++s2) { u32x4 pw; pw.x = pk2(sc[kt][8 * s2 + 0] * inv, sc[kt][8 * s2 + 1] * inv); pw.y = pk2(sc[kt][8 * s2 + 2] * inv, sc[kt][8 * s2 + 3] * inv);
            pw.z = pk2(sc[kt][8 * s2 + 4] * inv, sc[kt][8 * s2 + 5] * inv); pw.w = pk2(sc[kt][8 * s2 + 6] * inv, sc[kt][8 * s2 + 7] * inv); const bf16x8 pb = __builtin_bit_cast(bf16x8, pw);
#pragma unroll
            for (int dt = 0; dt < 2; ++dt) { const bf16_t* vp = Vt + (32 * dt + r) * 264 + j0 + 32 * kt + 16 * s2 + 4 * hh; const s16x4 v0 = *(const s16x4*)vp, v1 = *(const s16x4*)(vp + 8);
                const bf16x8 vf = __builtin_shufflevector(v0, v1, 0, 1, 2, 3, 4, 5, 6, 7); o[dt] = MFMA32(vf, pb, o[dt]); } }
#pragma unroll
    for (int dt = 0; dt < 2; ++dt)
#pragma unroll
        for (int g4 = 0; g4 < 4; ++g4) *(uint2*)(optr + 32 * dt + 8 * g4 + 4 * hh) = make_uint2(pk2(o[dt][4 * g4], o[dt][4 * g4 + 1]), pk2(o[dt][4 * g4 + 2], o[dt][4 * g4 + 3]));
}
DI void attn_item(const Params& p, int item) {
    extern __shared__ __attribute__((aligned(16))) unsigned char shm[];
    unsigned char* ws = p.ws; const bf16_t* PROJ = (const bf16_t*)(ws + WS_PROJ); bf16_t* MIX = (bf16_t*)p.out;
    const int tid = opaque_tid(), wid = tid >> 6, lane = tid & 63, r = lane & 31;
    if (item < 256) {
        const int kvh = item & 1, blk = (item >> 1) & 63, b = item >> 7; bf16_t* Ks = (bf16_t*)shm; bf16_t* Vt = (bf16_t*)(shm + 256 * 72 * 2);
        for (int idx = tid; idx < 2048; idx += NTHREADS) { const int key = idx >> 3, d8 = (idx & 7) * 8; const int pos = blk * 128 - 128 + key; uint4 kv = make_uint4(0, 0, 0, 0), vv = make_uint4(0, 0, 0, 0);
            if (pos >= 0) { const bf16_t* src = PROJ + (size_t)(b * 8192 + pos) * 2560 + 512 + kvh * 64 + d8; kv = *(const uint4*)src; vv = *(const uint4*)(src + 128); }
            *(uint4*)(Ks + key * 72 + d8) = kv; bf16_t* vt = Vt + d8 * 264 + key;
            vt[0] = (bf16_t)(vv.x & 0xffff); vt[264] = (bf16_t)(vv.x >> 16); vt[2 * 264] = (bf16_t)(vv.y & 0xffff); vt[3 * 264] = (bf16_t)(vv.y >> 16);
            vt[4 * 264] = (bf16_t)(vv.z & 0xffff); vt[5 * 264] = (bf16_t)(vv.z >> 16); vt[6 * 264] = (bf16_t)(vv.w & 0xffff); vt[7 * 264] = (bf16_t)(vv.w >> 16); }
        __syncthreads();
#pragma unroll 1
        for (int it = 0; it < 2; ++it) { const int ti = wid * 2 + it, g = ti >> 2, qs = (ti & 3) * 32; const int head = kvh * 4 + g; const int m = b * 8192 + blk * 128 + qs + r;
            int lo = qs + r + 1; if (blk == 0 && lo < 128) lo = 128;
            attn_wave_tile(Ks, Vt, qs, PROJ + (size_t)m * 2560 + head * 64, lo, qs + r + 128, p.in[I_SINK][head], MIX + (size_t)m * 1024 + head * 64); }
        __syncthreads();
    } else {
        const int b = item - 256; bf16_t* Ks = (bf16_t*)shm; bf16_t* Vt = (bf16_t*)(shm + 320 * 72 * 2);
        for (int idx = tid; idx < 2 * 160 * 8; idx += NTHREADS) { const int kvh = idx / 1280, rem = idx % 1280, key = rem >> 3, d8 = (rem & 7) * 8; uint4 kv = make_uint4(0, 0, 0, 0), vv = make_uint4(0, 0, 0, 0);
            if (key < 128) { const size_t o = ((size_t)(b * 128 + key) * 2 + kvh) * 64 + d8; const float4 k0 = *(const float4*)(p.in[I_CK] + o), k1 = *(const float4*)(p.in[I_CK] + o + 4), v0 = *(const float4*)(p.in[I_CV] + o), v1 = *(const float4*)(p.in[I_CV] + o + 4);
                kv = make_uint4(pk2(k0.x, k0.y), pk2(k0.z, k0.w), pk2(k1.x, k1.y), pk2(k1.z, k1.w)); vv = make_uint4(pk2(v0.x, v0.y), pk2(v0.z, v0.w), pk2(v1.x, v1.y), pk2(v1.z, v1.w)); }
            else if (key < 136) { const bf16_t* src = PROJ + (size_t)(NP + b * 8 + key - 128) * 2560 + 512 + kvh * 64 + d8; kv = *(const uint4*)src; vv = *(const uint4*)(src + 128); }
            *(uint4*)(Ks + (kvh * 160 + key) * 72 + d8) = kv; bf16_t* vt = Vt + (kvh * 64 + d8) * 264 + key;
            vt[0] = (bf16_t)(vv.x & 0xffff); vt[264] = (bf16_t)(vv.x >> 16); vt[2 * 264] = (bf16_t)(vv.y & 0xffff); vt[3 * 264] = (bf16_t)(vv.y >> 16);
            vt[4 * 264] = (bf16_t)(vv.z & 0xffff); vt[5 * 264] = (bf16_t)(vv.z >> 16); vt[6 * 264] = (bf16_t)(vv.w & 0xffff); vt[7 * 264] = (bf16_t)(vv.w >> 16); }
        __syncthreads();
        if (wid < 2) { const int kvh = wid, g = r >> 3, t = r & 7, head = kvh * 4 + g, m = NP + b * 8 + t;
            attn_wave_tile(Ks + kvh * 160 * 72, Vt + kvh * 64 * 264, 0, PROJ + (size_t)m * 2560 + head * 64, t + 1, t + 128, p.in[I_SINK][head], MIX + (size_t)m * 1024 + head * 64); }
        __syncthreads();
    }
}

DI void phase_scan_sample(const Params& p) {
    extern __shared__ __attribute__((aligned(16))) unsigned char shm[];
    unsigned char* ws = p.ws; const int tid = opaque_tid(), wid = tid >> 6, lane = tid & 63;
    bf16_t* Rb = (bf16_t*)(ws + WS_R); const bf16_t* Kb = (const bf16_t*)(ws + WS_K); const bf16_t* Vb = (const bf16_t*)(ws + WS_V); const bf16_t* Ab = (const bf16_t*)(ws + WS_A); const bf16_t* Bb = (const bf16_t*)(ws + WS_B);
    const float* Wf = (const float*)(ws + WS_W); float* L = (float*)shm + wid * 2560;
    if (blockIdx.x < 64) return;
    for (int item = wid * (gridDim.x - 64) + (blockIdx.x - 64); item < 1024; item += 8 * (gridDim.x - 64)) {
        int m0, T, h; float* sout; float S[64];
        { const int s = item, b = s >> 3; h = s & 7; m0 = NP + b * 8; T = 8; sout = p.out + O_SS + ((size_t)(b * 8 + h) * 64 + lane) * 64; const float* sin = p.in[I_SW] + ((size_t)(b * 8 + h) * 64 + lane) * 64;
#pragma unroll
            for (int k4 = 0; k4 < 16; ++k4) { const float4 v = *(const float4*)(sin + 4 * k4); S[4 * k4] = v.x; S[4 * k4 + 1] = v.y; S[4 * k4 + 2] = v.z; S[4 * k4 + 3] = v.w; } }
#pragma unroll 1
        for (int t0 = 0; t0 < T; t0 += 8) {
            { const int st = lane >> 3, c8 = (lane & 7) * 8; const size_t o = (size_t)(m0 + t0 + st) * 512 + h * 64 + c8; float* l = L + st * 320 + c8;
                const uint4 ur = *(const uint4*)(Rb + o), uk = *(const uint4*)(Kb + o), ua = *(const uint4*)(Ab + o), ub = *(const uint4*)(Bb + o); const float4 w0 = *(const float4*)(Wf + o), w1 = *(const float4*)(Wf + o + 4);
                *(float4*)(l) = make_float4(bflo(ua.x), bfhi(ua.x), bflo(ua.y), bfhi(ua.y)); *(float4*)(l + 4) = make_float4(bflo(ua.z), bfhi(ua.z), bflo(ua.w), bfhi(ua.w));
                *(float4*)(l + 64) = make_float4(__expf(w0.x), __expf(w0.y), __expf(w0.z), __expf(w0.w)); *(float4*)(l + 68) = make_float4(__expf(w1.x), __expf(w1.y), __expf(w1.z), __expf(w1.w));
                *(float4*)(l + 128) = make_float4(bflo(ub.x), bfhi(ub.x), bflo(ub.y), bfhi(ub.y)); *(float4*)(l + 132) = make_float4(bflo(ub.z), bfhi(ub.z), bflo(ub.w), bfhi(ub.w));
                *(float4*)(l + 192) = make_float4(bflo(uk.x), bfhi(uk.x), bflo(uk.y), bfhi(uk.y)); *(float4*)(l + 196) = make_float4(bflo(uk.z), bfhi(uk.z), bflo(uk.w), bfhi(uk.w));
                *(float4*)(l + 256) = make_float4(bflo(ur.x), bfhi(ur.x), bflo(ur.y), bfhi(ur.y)); *(float4*)(l + 260) = make_float4(bflo(ur.z), bfhi(ur.z), bflo(ur.w), bfhi(ur.w)); }
            float vv[8];
#pragma unroll
            for (int j = 0; j < 8; ++j) vv[j] = bf1(Vb[(size_t)(m0 + t0 + j) * 512 + h * 64 + lane]);
            __builtin_amdgcn_fence(__ATOMIC_RELEASE, "wavefront"); __builtin_amdgcn_wave_barrier(); __builtin_amdgcn_fence(__ATOMIC_ACQUIRE, "wavefront");
#pragma unroll 1
            for (int j = 0; j < 8; ++j) { const float* l = L + j * 320; float sa = 0.f;
#pragma unroll
                for (int k4 = 0; k4 < 16; ++k4) { const float4 a = *(const float4*)(l + 4 * k4); sa += S[4 * k4] * a.x + S[4 * k4 + 1] * a.y + S[4 * k4 + 2] * a.z + S[4 * k4 + 3] * a.w; }
                float vj = vv[0];
#pragma unroll
                for (int q = 1; q < 8; ++q) vj = (j == q) ? vv[q] : vj;
                float o = 0.f;
#pragma unroll
                for (int k4 = 0; k4 < 16; ++k4) { const float4 w = *(const float4*)(l + 64 + 4 * k4), bq = *(const float4*)(l + 128 + 4 * k4), kq = *(const float4*)(l + 192 + 4 * k4), rq = *(const float4*)(l + 256 + 4 * k4);
                    S[4 * k4] = S[4 * k4] * w.x + sa * bq.x + vj * kq.x; S[4 * k4 + 1] = S[4 * k4 + 1] * w.y + sa * bq.y + vj * kq.y; S[4 * k4 + 2] = S[4 * k4 + 2] * w.z + sa * bq.z + vj * kq.z; S[4 * k4 + 3] = S[4 * k4 + 3] * w.w + sa * bq.w + vj * kq.w;
                    o += S[4 * k4] * rq.x + S[4 * k4 + 1] * rq.y + S[4 * k4 + 2] * rq.z + S[4 * k4 + 3] * rq.w; }
                Rb[(size_t)(m0 + t0 + j) * 512 + h * 64 + lane] = (bf16_t)(pk2(o, 0.f) & 0xffff); }
            __builtin_amdgcn_fence(__ATOMIC_RELEASE, "wavefront"); __builtin_amdgcn_wave_barrier(); __builtin_amdgcn_fence(__ATOMIC_ACQUIRE, "wavefront");
        }
#pragma unroll
        for (int k4 = 0; k4 < 16; ++k4) *(float4*)(sout + 4 * k4) = make_float4(S[4 * k4], S[4 * k4 + 1], S[4 * k4 + 2], S[4 * k4 + 3]);
    }
}

DI void phase_post(const Params& p) {
    unsigned char* ws = p.ws; const int tid = opaque_tid(), wid = tid >> 6, lane = tid & 63; bf16_t* MIX = (bf16_t*)p.out;
    const bf16_t* Ob = (const bf16_t*)(ws + WS_R); const bf16_t* Vb = (const bf16_t*)(ws + WS_V); const bf16_t* Gb = (const bf16_t*)(ws + WS_G); const float* BON = (const float*)(ws + WS_BONUS);
    const int h = lane >> 3, c8 = h * 64 + (lane & 7) * 8;
    float gg[8], gb[8];
#pragma unroll
    for (int j = 0; j < 8; ++j) { gg[j] = p.in[I_GNG][c8 + j]; gb[j] = p.in[I_GNB][c8 + j]; }
    for (int m = NP + blockIdx.x * 8 + wid; m < NTOK; m += gridDim.x * 8) { const size_t o = (size_t)m * 512 + c8;
        const uint4 uo = *(const uint4*)(Ob + o), uv = *(const uint4*)(Vb + o), ug = *(const uint4*)(Gb + o); const float bon = BON[(size_t)m * 8 + h];
        float x[8] = {bflo(uo.x), bfhi(uo.x), bflo(uo.y), bfhi(uo.y), bflo(uo.z), bfhi(uo.z), bflo(uo.w), bfhi(uo.w)};
        const float v[8] = {bflo(uv.x), bfhi(uv.x), bflo(uv.y), bfhi(uv.y), bflo(uv.z), bfhi(uv.z), bflo(uv.w), bfhi(uv.w)};
        const float g[8] = {bflo(ug.x), bfhi(ug.x), bflo(ug.y), bfhi(ug.y), bflo(ug.z), bfhi(ug.z), bflo(ug.w), bfhi(ug.w)};
        float s = 0.f;
#pragma unroll
        for (int j = 0; j < 8; ++j) s += x[j];
        s += __shfl_xor(s, 1); s += __shfl_xor(s, 2); s += __shfl_xor(s, 4); const float mean = s * (1.0f / 64.0f); float q = 0.f;
#pragma unroll
        for (int j = 0; j < 8; ++j) { x[j] -= mean; q += x[j] * x[j]; }
        q += __shfl_xor(q, 1); q += __shfl_xor(q, 2); q += __shfl_xor(q, 4); const float rs = rsqrtf(q * (1.0f / 64.0f) + 64e-5f);
        float y[8];
#pragma unroll
        for (int j = 0; j < 8; ++j) y[j] = (x[j] * rs * gg[j] + gb[j] + bon * v[j]) * g[j];
        *(uint4*)(MIX + (size_t)m * 1024 + 512 + c8) = make_uint4(pk2(y[0], y[1]), pk2(y[2], y[3]), pk2(y[4], y[5]), pk2(y[6], y[7])); }
}

DI void phase_final(const Params& p) {
    unsigned char* ws = p.ws; const int tid = opaque_tid(), wid = tid >> 6, lane = tid & 63; const float* X2 = (const float*)(ws + WS_X1); const float* PART = (const float*)(ws + WS_PART); const float* gf = p.in[I_GFIN];
    float4 g[4];
#pragma unroll
    for (int i = 0; i < 4; ++i) g[i] = *(const float4*)(gf + lane * 4 + 256 * i);
    for (int m = blockIdx.x * 8 + wid; m < NTOK; m += gridDim.x * 8) { float4 v[4]; float sq = 0.f;
#pragma unroll
        for (int i = 0; i < 4; ++i) { const uint2 xb = *(const uint2*)((const bf16_t*)(ws + WS_X1B) + (size_t)m * 1024 + lane * 4 + 256 * i); v[i] = make_float4(bflo(xb.x), bfhi(xb.x), bflo(xb.y), bfhi(xb.y)); }
        if (m >= NP) {
#pragma unroll
            for (int sl = 0; sl < 4; ++sl)
#pragma unroll
                for (int i = 0; i < 4; ++i) { const float4 q = *(const float4*)(PART + (size_t)sl * 1048576 + (size_t)(m - NP) * 1024 + lane * 4 + 256 * i); v[i].x += q.x; v[i].y += q.y; v[i].z += q.z; v[i].w += q.w; } }
#pragma unroll
        for (int i = 0; i < 4; ++i) sq += v[i].x * v[i].x + v[i].y * v[i].y + v[i].z * v[i].z + v[i].w * v[i].w;
#pragma unroll
        for (int o = 32; o >= 1; o >>= 1) sq += __shfl_xor(sq, o);
        const float rstd = rsqrtf(sq * (1.0f / 1024.0f) + 1e-6f);
#pragma unroll
        for (int i = 0; i < 4; ++i) { float4 y = v[i]; y.x *= rstd * g[i].x; y.y *= rstd * g[i].y; y.z *= rstd * g[i].z; y.w *= rstd * g[i].w;
            *(float4*)(p.out + O_Y + (size_t)m * 1024 + lane * 4 + 256 * i) = y; } }
}

constexpr int CS_AT = 0, CS_BT = 9216, CS_KT = 18432, CS_RT = 27648, CS_VT = 36864, CS_BHT = 46080, CS_KHT = 55296, CS_ADG = 64512, CS_AABB = 68608, CS_AAK = 81920, CS_ARB = 91136, CS_ARK = 100352, CS_RHS = 109568, CS_TOT = 142336, CS_GC = 144384;
DI bf16x8 ldsfrag(const bf16_t* base, int row, int s, int hh) { return *(const bf16x8*)(base + row * 72 + 16 * s + 8 * hh); }
struct ChunkRaw { float lw[8]; bf16_t a[8], b[8], k[8], r[8], v[8]; };
#define LBAR() do { asm volatile("s_waitcnt lgkmcnt(0)" ::: "memory"); __builtin_amdgcn_s_barrier(); asm volatile("" ::: "memory"); } while (0)
DI void chunk_load(const Params& p, int item, ChunkRaw& q) {
    unsigned char* ws = p.ws; const int tid_ = opaque_tid(), wid = tid_ >> 6, lane = tid_ & 63; const int sh = item >> 7, c = item & 127, b = sh >> 3, h = sh & 7, m0 = b * 8192 + c * 64;
    const size_t base = (size_t)(m0 + 8 * wid) * 512 + h * 64 + lane;
    const bf16_t* Rb = (const bf16_t*)(ws + WS_R); const bf16_t* Kb = (const bf16_t*)(ws + WS_K); const bf16_t* Vb = (const bf16_t*)(ws + WS_V); const bf16_t* Ab = (const bf16_t*)(ws + WS_A); const bf16_t* Bb = (const bf16_t*)(ws + WS_B); const float* Wf = (const float*)(ws + WS_W);
#pragma unroll
    for (int j = 0; j < 8; ++j) { q.lw[j] = Wf[base + j * 512]; q.a[j] = Ab[base + j * 512]; q.b[j] = Bb[base + j * 512]; q.k[j] = Kb[base + j * 512]; q.r[j] = Rb[base + j * 512]; q.v[j] = Vb[base + j * 512]; }
}
#ifdef PROBE_CH
#define CHT(i) do { const unsigned long long _t = wall_clock64(); cht[i] += _t - chl; chl = _t; } while (0)
DI void chunk_item(const Params& p, int item, int next_item, ChunkRaw& raw, unsigned long long* cht, unsigned long long& chl) {
#else
#define CHT(i) do {} while (0)
DI void chunk_item(const Params& p, int item, int next_item, ChunkRaw& raw) {
#endif
    extern __shared__ __attribute__((aligned(16))) unsigned char shm[];
    unsigned char* ws = p.ws; const int tid = opaque_tid(), wid = tid >> 6, lane = tid & 63, r = lane & 31, hh = lane >> 5;
    const int sh = item >> 7, c = item & 127, b = sh >> 3, h = sh & 7, m0 = b * 8192 + c * 64;
    bf16_t* AT = (bf16_t*)(shm + CS_AT); bf16_t* BT = (bf16_t*)(shm + CS_BT); bf16_t* KT = (bf16_t*)(shm + CS_KT); bf16_t* RT = (bf16_t*)(shm + CS_RT);
    bf16_t* VT = (bf16_t*)(shm + CS_VT); bf16_t* BHT = (bf16_t*)(shm + CS_BHT); bf16_t* KHT = (bf16_t*)(shm + CS_KHT); float* ADG = (float*)(shm + CS_ADG); bf16_t* AABb = (bf16_t*)(shm + CS_AABB);
    bf16_t* AAK = (bf16_t*)(shm + CS_AAK); bf16_t* ARB = (bf16_t*)(shm + CS_ARB); bf16_t* ARK = (bf16_t*)(shm + CS_ARK); float* RHS = (float*)(shm + CS_RHS);
    float* TOT = (float*)(shm + CS_TOT); float* GC = (float*)(shm + CS_GC); bf16_t* W1T = AT; bf16_t* W2T = BT;
    const bf16_t* Rb = (const bf16_t*)(ws + WS_R); const bf16_t* Kb = (const bf16_t*)(ws + WS_K); const bf16_t* Vb = (const bf16_t*)(ws + WS_V); const bf16_t* Ab = (const bf16_t*)(ws + WS_A); const bf16_t* Bb = (const bf16_t*)(ws + WS_B);
    float* Wf = (float*)(ws + WS_W);
#ifndef NO_S1
    {
        const int k = lane;
        float lw[8], cs[8], av[8], bv[8], kv[8], rv[8], vv[8];
#pragma unroll
        for (int j = 0; j < 8; ++j) { lw[j] = raw.lw[j]; av[j] = bf1(raw.a[j]); bv[j] = bf1(raw.b[j]); kv[j] = bf1(raw.k[j]); rv[j] = bf1(raw.r[j]); vv[j] = bf1(raw.v[j]); }
        cs[0] = lw[0];
#pragma unroll
        for (int j = 1; j < 8; ++j) cs[j] = cs[j - 1] + lw[j];
        TOT[wid * 64 + k] = cs[7];
        LBAR();
        float off = 0.f, tot = 0.f;
#pragma unroll
        for (int ww = 0; ww < 8; ++ww) { const float x = TOT[ww * 64 + k]; off += (ww < wid) ? x : 0.f; tot += x; }
        float bh8[8], kh8[8];
        const float etot = __expf(tot); float gprev = __expf(off + cs[0] - lw[0]);
#pragma unroll
        for (int j = 0; j < 8; ++j) { const int t = 8 * wid + j; const float cc = off + cs[j]; const float g = __expf(cc), gi = __builtin_amdgcn_rcpf(g), gp = gprev, gh = etot * gi; gprev = g;
            const float at = av[j] * gp; AT[t * 72 + k] = (bf16_t)(pk2(at, 0.f) & 0xffff); BT[t * 72 + k] = (bf16_t)(pk2(bv[j] * gi, 0.f) & 0xffff); KT[t * 72 + k] = (bf16_t)(pk2(kv[j] * gi, 0.f) & 0xffff);
            RT[t * 72 + k] = (bf16_t)(pk2(rv[j] * g, 0.f) & 0xffff); RHS[t * 128 + k] = at; bh8[j] = bv[j] * gh; kh8[j] = kv[j] * gh; }
        *(uint4*)(VT + k * 72 + 8 * wid) = make_uint4(pk2(vv[0], vv[1]), pk2(vv[2], vv[3]), pk2(vv[4], vv[5]), pk2(vv[6], vv[7]));
        *(uint4*)(BHT + k * 72 + 8 * wid) = make_uint4(pk2(bh8[0], bh8[1]), pk2(bh8[2], bh8[3]), pk2(bh8[4], bh8[5]), pk2(bh8[6], bh8[7]));
        *(uint4*)(KHT + k * 72 + 8 * wid) = make_uint4(pk2(kh8[0], kh8[1]), pk2(kh8[2], kh8[3]), pk2(kh8[4], kh8[5]), pk2(kh8[6], kh8[7]));
        if (wid == 0) GC[k] = __expf(tot);
    }
    if (next_item < 2048) chunk_load(p, next_item, raw);
#endif
    LBAR();
    CHT(0);
#ifndef NO_S2
#pragma unroll
    for (int i2 = 0; i2 < 2; ++i2) { const int job = wid * 2 + i2, mi = job >> 2, tt = (job >> 1) & 1, jt = job & 1;
        f32x16 D;
#pragma unroll
        for (int i = 0; i < 16; ++i) D[i] = 0.f;
        if (!(tt == 0 && jt == 1)) { const bf16_t* Lop = (mi < 2) ? AT : RT; const bf16_t* Rop = (mi & 1) ? KT : BT;
#pragma unroll
            for (int s = 0; s < 4; ++s) D = MFMA32(ldsfrag(Rop, 32 * jt + r, s, hh), ldsfrag(Lop, 32 * tt + r, s, hh), D); }
        const int t = 32 * tt + r;
#pragma unroll
        for (int g4 = 0; g4 < 4; ++g4) { const int j0 = 32 * jt + 8 * g4 + 4 * hh; float v[4];
#pragma unroll
            for (int e = 0; e < 4; ++e) { const int j = j0 + e; const bool ok = (mi < 2) ? (j < t) : (j <= t); v[e] = ok ? D[4 * g4 + e] : 0.f; }
            if (mi == 0 && (t >> 4) == (j0 >> 4)) *(float4*)(ADG + (t >> 4) * 256 + (t & 15) * 16 + (j0 & 15)) = make_float4(v[0], v[1], v[2], v[3]);
            { bf16_t* dst = (mi == 0 ? AABb : (mi == 1 ? AAK : (mi == 2 ? ARB : ARK))) + t * 72 + j0; *(uint2*)dst = make_uint2(pk2(v[0], v[1]), pk2(v[2], v[3])); } } }
#endif
    LBAR();
    CHT(1);
    bf16_t* TINV = (bf16_t*)(shm + CS_TOT);
    if (wid == 4) { const int Ib = lane >> 4, cc = lane & 15; const float* dg = ADG + Ib * 256; float t[16];
#pragma unroll
        for (int rr = 0; rr < 16; ++rr) t[rr] = (rr == cc) ? 1.f : 0.f;
#pragma unroll
        for (int rr = 1; rr < 16; ++rr) { float part[4] = {0.f, 0.f, 0.f, 0.f};
#pragma unroll
            for (int g = 0; g < (rr + 3) / 4; ++g) { const float4 av = *(const float4*)(dg + rr * 16 + 4 * g); part[g] = av.x * t[4 * g] + av.y * t[4 * g + 1] + av.z * t[4 * g + 2] + av.w * t[4 * g + 3]; }
            t[rr] += (part[0] + part[1]) + (part[2] + part[3]); }
#pragma unroll
        for (int rr = 0; rr < 16; ++rr) TINV[(Ib * 16 + rr) * 16 + cc] = (bf16_t)(pk2a(t[rr], 0.f) & 0xffffu); }
    if (wid < 4) { const int tt = wid >> 1, vt = wid & 1; f32x16 D;
#pragma unroll
        for (int i = 0; i < 16; ++i) D[i] = 0.f;
#pragma unroll
        for (int s = 0; s < 4; ++s) D = MFMA32(ldsfrag(AAK, 32 * tt + r, s, hh), ldsfrag(VT, 32 * vt + r, s, hh), D);
#pragma unroll
        for (int i = 0; i < 16; ++i) RHS[(32 * tt + (i & 3) + 8 * (i >> 2) + 4 * hh) * 128 + 64 + 32 * vt + r] = D[i]; }
    LBAR();
    CHT(2);
#ifndef NO_S4
    { const int cl = lane & 15, q4 = lane >> 4, col = 16 * wid + cl, s0 = cl + 32 * (q4 & 1), s1 = s0 + 16;
        f32x4 R[4];
#pragma unroll
        for (int T = 0; T < 4; ++T)
#pragma unroll
            for (int e = 0; e < 4; ++e) R[T][e] = RHS[(16 * T + 4 * q4 + e) * 128 + col];
        bf16_t* wt = (col < 64) ? (W1T + col * 72) : (W2T + (col - 64) * 72);
#define CS_BFRAG(V, out) { const float b0 = __shfl(V[0], s0), b1 = __shfl(V[1], s0), b2 = __shfl(V[2], s0), b3 = __shfl(V[3], s0), b4 = __shfl(V[0], s1), b5 = __shfl(V[1], s1), b6 = __shfl(V[2], s1), b7 = __shfl(V[3], s1); \
            u32x4 bw_; bw_.x = pk2(b0, b1); bw_.y = pk2(b2, b3); bw_.z = pk2(b4, b5); bw_.w = pk2(b6, b7); if (q4 >= 2) bw_ = (u32x4){0u, 0u, 0u, 0u}; out = __builtin_bit_cast(bf16x8, bw_); }
#pragma unroll
        for (int I = 0; I < 4; ++I) { bf16x8 rb; CS_BFRAG(R[I], rb)
            u32x4 tw = *(const u32x4*)(TINV + (I * 16 + cl) * 16 + 8 * (q4 & 1)); if (q4 >= 2) tw = (u32x4){0u, 0u, 0u, 0u};
            const f32x4 X = MFMA16(__builtin_bit_cast(bf16x8, tw), rb, ((f32x4){0.f, 0.f, 0.f, 0.f}));
            *(uint2*)(wt + 16 * I + 4 * q4) = make_uint2(pk2(X[0], X[1]), pk2(X[2], X[3]));
            if (I < 3) { bf16x8 xb; CS_BFRAG(X, xb)
#pragma unroll
                for (int T = I + 1; T < 4; ++T) { u32x4 aw = *(const u32x4*)(AABb + (16 * T + cl) * 72 + 16 * I + 8 * (q4 & 1)); if (q4 >= 2) aw = (u32x4){0u, 0u, 0u, 0u};
                    R[T] = MFMA16(__builtin_bit_cast(bf16x8, aw), xb, R[T]); } }
        }
#undef CS_BFRAG
    }
#endif
    LBAR();
    CHT(3);
#ifndef NO_S5
    bf16_t* MTg = (bf16_t*)(ws + WS_MT) + (size_t)item * 4096; float* Ng = (float*)(ws + WS_N) + (size_t)item * 4096; bf16_t* QTg = (bf16_t*)(ws + WS_QT) + (size_t)item * 4096;
#pragma unroll
    for (int i2 = 0; i2 < 2; ++i2) { const int job = wid * 2 + i2, kind = job >> 2, ta = (job >> 1) & 1, tb = job & 1;
        const bf16_t* A1 = (kind == 0 || kind == 2) ? W1T : (kind == 1 ? W2T : BHT); const bf16_t* B1 = (kind < 2) ? ARB : (kind == 2 ? BHT : W2T);
        f32x16 D;
#pragma unroll
        for (int i = 0; i < 16; ++i) D[i] = 0.f;
#pragma unroll
        for (int s = 0; s < 4; ++s) D = MFMA32(ldsfrag(A1, 32 * tb + r, s, hh), ldsfrag(B1, 32 * ta + r, s, hh), D);
        if (kind & 1) { const bf16_t* A2 = (kind == 1) ? VT : KHT; const bf16_t* B2 = (kind == 1) ? ARK : VT;
#pragma unroll
            for (int s = 0; s < 4; ++s) D = MFMA32(ldsfrag(A2, 32 * tb + r, s, hh), ldsfrag(B2, 32 * ta + r, s, hh), D); }
        const int col = 32 * ta + r;
#pragma unroll
        for (int g4 = 0; g4 < 4; ++g4) { const int r0 = 32 * tb + 8 * g4 + 4 * hh;
            float v[4] = {D[4 * g4], D[4 * g4 + 1], D[4 * g4 + 2], D[4 * g4 + 3]};
            if (kind == 0) { float q[4]; load4bf(RT + col * 72 + r0, q); *(uint2*)(QTg + col * 64 + r0) = make_uint2(pk2(v[0] + q[0], v[1] + q[1]), pk2(v[2] + q[2], v[3] + q[3])); }
            else if (kind == 1) { *(uint2*)((bf16_t*)(ws + WS_R) + (size_t)(m0 + col) * 512 + h * 64 + r0) = make_uint2(pk2(v[0], v[1]), pk2(v[2], v[3])); }
            else if (kind == 2) {
#pragma unroll
                for (int e = 0; e < 4; ++e) if (r0 + e == col) v[e] += GC[col];
                *(uint2*)(MTg + col * 64 + r0) = make_uint2(pk2(v[0], v[1]), pk2(v[2], v[3])); }
            else { *(float4*)(Ng + col * 64 + r0) = make_float4(v[0], v[1], v[2], v[3]); } } }
#endif
    LBAR();
    CHT(4);
}

constexpr int PR_NCH = 64, PR_SLOT = 13568, PR_NSLOT = 8, PR_FLAGS = PR_SLOT * PR_NSLOT;
DI void phase_prop(const Params& p) {
    extern __shared__ __attribute__((aligned(16))) unsigned char shm[];
    unsigned char* ws = p.ws; const int tid = opaque_tid(), wid = tid >> 6, lane = tid & 63, vl = lane & 15, q = lane >> 4;
    if (blockIdx.x >= PR_NCH) { phase_scan_sample(p); return; }
    int* flags = (int*)(shm + PR_FLAGS);
    if (tid < 16) flags[tid] = 0;
    __syncthreads();
    const int sh = blockIdx.x >> 2, vq = blockIdx.x & 3, vrow = 16 * vq + vl;
    if (wid > 0) {
        const uint4* MtB = (const uint4*)((const bf16_t*)(ws + WS_MT) + (size_t)sh * 128 * 4096) + lane; const uint4* NgB = (const uint4*)((const float*)(ws + WS_N) + (size_t)sh * 128 * 4096 + vq * 1024) + lane;
#define PR_LD(S, k) S##m##k = MtB[(size_t)cc * 512 + 64 * k];
#define PR_LDN(S, k) S##n##k = NgB[(size_t)cc * 1024 + 64 * k];
#define PR_LOAD(S, step) { const int cc = (step); PR_LD(S, 0) PR_LD(S, 1) PR_LD(S, 2) PR_LD(S, 3) PR_LD(S, 4) PR_LD(S, 5) PR_LD(S, 6) PR_LD(S, 7) PR_LDN(S, 0) PR_LDN(S, 1) PR_LDN(S, 2) PR_LDN(S, 3) }
#define PR_ST(S, k) { const int im = lane + 64 * k; *(uint4*)(slot + (im >> 3) * 144 + (im & 7) * 16) = S##m##k; }
#define PR_STN(S, k) { const int im = lane + 64 * k; *(uint4*)(slot + 9216 + (im >> 4) * 272 + (im & 15) * 16) = S##n##k; }
#define PR_STORE(S, step) { const int cc = (step); while (__hip_atomic_load(flags + 8, __ATOMIC_ACQUIRE, __HIP_MEMORY_SCOPE_WORKGROUP) < cc - 7) __builtin_amdgcn_s_sleep(1); \
            unsigned char* slot = shm + (cc & 7) * PR_SLOT; PR_ST(S, 0) PR_ST(S, 1) PR_ST(S, 2) PR_ST(S, 3) PR_ST(S, 4) PR_ST(S, 5) PR_ST(S, 6) PR_ST(S, 7) PR_STN(S, 0) PR_STN(S, 1) PR_STN(S, 2) PR_STN(S, 3) \
            __hip_atomic_store(flags + (cc & 7), cc + 1, __ATOMIC_RELEASE, __HIP_MEMORY_SCOPE_WORKGROUP); }
        uint4 Am0, Am1, Am2, Am3, Am4, Am5, Am6, Am7, An0, An1, An2, An3, Bm0, Bm1, Bm2, Bm3, Bm4, Bm5, Bm6, Bm7, Bn0, Bn1, Bn2, Bn3;
        int c = wid - 1;
        PR_LOAD(A, c)
#pragma unroll 1
        for (; c < 128; c += 14) {
            if (c + 7 < 128) PR_LOAD(B, c + 7)
            PR_STORE(A, c)
            if (c + 14 < 128) PR_LOAD(A, c + 14)
            if (c + 7 < 128) PR_STORE(B, c + 7)
        }
#undef PR_LD
#undef PR_LDN
#undef PR_LOAD
#undef PR_ST
#undef PR_STN
#undef PR_STORE
        return;
    }
    f32x4 acc[4]; bf16x8 Sb[2];
#pragma unroll
    for (int nt = 0; nt < 4; ++nt) acc[nt] = (f32x4){0.f, 0.f, 0.f, 0.f};
    Sb[0] = (bf16x8){0, 0, 0, 0, 0, 0, 0, 0}; Sb[1] = Sb[0];
#pragma unroll 1
    for (int c = 0; c < 128; ++c) { const size_t item = (size_t)sh * 128 + c; bf16_t* SC = (bf16_t*)(ws + WS_SC) + item * 4096; const unsigned char* slot = shm + (c & 7) * PR_SLOT;
#pragma unroll
        for (int s = 0; s < 2; ++s) { const u32x4 u = __builtin_bit_cast(u32x4, Sb[s]); *(uint2*)(SC + vrow * 64 + 32 * s + 4 * q) = make_uint2(u.x, u.y); *(uint2*)(SC + vrow * 64 + 32 * s + 16 + 4 * q) = make_uint2(u.z, u.w); }
        while (__hip_atomic_load(flags + (c & 7), __ATOMIC_ACQUIRE, __HIP_MEMORY_SCOPE_WORKGROUP) != c + 1) __builtin_amdgcn_s_sleep(1);
#pragma unroll
        for (int nt = 0; nt < 4; ++nt) acc[nt] = *(const f32x4*)(slot + 9216 + vl * 272 + (16 * nt + 4 * q) * 4);
        bf16x8 mf[2][4];
#pragma unroll
        for (int s = 0; s < 2; ++s)
#pragma unroll
            for (int nt = 0; nt < 4; ++nt) { const unsigned char* mp = slot + (16 * nt + vl) * 144 + (32 * s + 4 * q) * 2; const s16x4 a0 = *(const s16x4*)mp, a1 = *(const s16x4*)(mp + 32); mf[s][nt] = __builtin_shufflevector(a0, a1, 0, 1, 2, 3, 4, 5, 6, 7); }
        asm volatile("s_waitcnt lgkmcnt(0)" ::: "memory");
        __builtin_amdgcn_sched_barrier(0);
        __hip_atomic_store(flags + 8, c + 1, __ATOMIC_RELAXED, __HIP_MEMORY_SCOPE_WORKGROUP);
#pragma unroll
        for (int s = 0; s < 2; ++s)
#pragma unroll
            for (int nt = 0; nt < 4; ++nt) acc[nt] = MFMA16(mf[s][nt], Sb[s], acc[nt]);
#pragma unroll
        for (int s = 0; s < 2; ++s) { u32x4 u; u.x = pk2(acc[2 * s][0], acc[2 * s][1]); u.y = pk2(acc[2 * s][2], acc[2 * s][3]); u.z = pk2(acc[2 * s + 1][0], acc[2 * s + 1][1]); u.w = pk2(acc[2 * s + 1][2], acc[2 * s + 1][3]);
            Sb[s] = __builtin_bit_cast(bf16x8, u); }
    }
    float* so = p.out + O_SP + ((size_t)sh * 64 + vrow) * 64;
#pragma unroll
    for (int nt = 0; nt < 4; ++nt) *(f32x4*)(so + 16 * nt + 4 * q) = acc[nt];
}

DI void phase_out(const Params& p) {
    unsigned char* ws = p.ws; const int tid = opaque_tid(), wid = tid >> 6, lane = tid & 63, r = lane & 31, hh = lane >> 5; bf16_t* MIX = (bf16_t*)p.out;
    const bf16_t* Vb = (const bf16_t*)(ws + WS_V); const bf16_t* Gb = (const bf16_t*)(ws + WS_G); const float* BON = (const float*)(ws + WS_BONUS); const bf16_t* OLb = (const bf16_t*)(ws + WS_R);
    for (int chunk = blockIdx.x; chunk < 256; chunk += gridDim.x) { const int b = chunk >> 7, c = chunk & 127, h = wid; const size_t item = (size_t)(b * 8 + h) * 128 + c; const int m0 = chunk * 64;
        const bf16_t* QTg = (const bf16_t*)(ws + WS_QT) + item * 4096; const bf16_t* SC = (const bf16_t*)(ws + WS_SC) + item * 4096;
#pragma unroll 1
        for (int tt = 0; tt < 2; ++tt) { f32x16 D[2];
#pragma unroll
            for (int i = 0; i < 16; ++i) { D[0][i] = 0.f; D[1][i] = 0.f; }
            bf16x8 bq[4], sf[4][2];
#pragma unroll
            for (int s = 0; s < 4; ++s) { bq[s] = *(const bf16x8*)(QTg + (32 * tt + r) * 64 + 16 * s + 8 * hh);
#pragma unroll
                for (int vt = 0; vt < 2; ++vt) sf[s][vt] = *(const bf16x8*)(SC + (32 * vt + r) * 64 + 16 * s + 8 * hh); }
#pragma unroll
            for (int s = 0; s < 4; ++s)
#pragma unroll
                for (int vt = 0; vt < 2; ++vt) D[vt] = MFMA32(sf[s][vt], bq[s], D[vt]);
            const int m = m0 + 32 * tt + r; const size_t ob = (size_t)m * 512 + h * 64 + 4 * hh; float sum = 0.f;
#pragma unroll
            for (int vt = 0; vt < 2; ++vt)
#pragma unroll
                for (int g4 = 0; g4 < 4; ++g4) { float ol[4]; load4bf(OLb + ob + 32 * vt + 8 * g4, ol); D[vt][4 * g4] += ol[0]; D[vt][4 * g4 + 1] += ol[1]; D[vt][4 * g4 + 2] += ol[2]; D[vt][4 * g4 + 3] += ol[3];
                    sum += D[vt][4 * g4] + D[vt][4 * g4 + 1] + D[vt][4 * g4 + 2] + D[vt][4 * g4 + 3]; }
            sum += __shfl_xor(sum, 32); const float mean = sum * (1.0f / 64.0f); float q = 0.f;
#pragma unroll
            for (int vt = 0; vt < 2; ++vt)
#pragma unroll
                for (int i = 0; i < 16; ++i) { D[vt][i] -= mean; q += D[vt][i] * D[vt][i]; }
            q += __shfl_xor(q, 32); const float rs = rsqrtf(q * (1.0f / 64.0f) + 64e-5f); const float bon = BON[(size_t)m * 8 + h];
#pragma unroll
            for (int vt = 0; vt < 2; ++vt)
#pragma unroll
                for (int g4 = 0; g4 < 4; ++g4) { const int c0 = 32 * vt + 8 * g4; const float4 gg = *(const float4*)(p.in[I_GNG] + h * 64 + 4 * hh + c0), gb = *(const float4*)(p.in[I_GNB] + h * 64 + 4 * hh + c0);
                    float v4[4], g4v[4]; load4bf(Vb + ob + c0, v4); load4bf(Gb + ob + c0, g4v);
                    const float y0 = (D[vt][4 * g4] * rs * gg.x + gb.x + bon * v4[0]) * g4v[0], y1 = (D[vt][4 * g4 + 1] * rs * gg.y + gb.y + bon * v4[1]) * g4v[1];
                    const float y2 = (D[vt][4 * g4 + 2] * rs * gg.z + gb.z + bon * v4[2]) * g4v[2], y3 = (D[vt][4 * g4 + 3] * rs * gg.w + gb.w + bon * v4[3]) * g4v[3];
                    *(uint2*)(MIX + (size_t)m * 1024 + 512 + h * 64 + 4 * hh + c0) = make_uint2(pk2(y0, y1), pk2(y2, y3)); }
        }
    }
    phase_post(p);
}

#define XB_TMO      128
#define XB_XCNT(j)  (256  + 64 * (j))
#define XB_XSUB(j)  (1280 + 64 * (j))
#define XB_XGEN(j)  (2304 + 64 * (j))
#define XB_TOP      3328
#define XB_TOPGEN   3392
#define XCD_BAR_WORDS 3456
#define XB_SPIN_CAP (1u << 18)
#define LAS __attribute__((address_space(3)))

__device__ __forceinline__ unsigned xb_ld(unsigned* p)              { return __hip_atomic_load(p, __ATOMIC_RELAXED, __HIP_MEMORY_SCOPE_AGENT); }
__device__ __forceinline__ unsigned xb_add(unsigned* p, unsigned v) { return __hip_atomic_fetch_add(p, v, __ATOMIC_RELAXED, __HIP_MEMORY_SCOPE_AGENT); }
__device__ __forceinline__ unsigned xb_xcc_id() { return (unsigned)__builtin_amdgcn_s_getreg((3 << 11) | 20) & 0xFu; }
#define XB_SPIN(cond, bar) do { unsigned _sp = 0; while (cond) { __builtin_amdgcn_s_sleep(1); \
    if ((++_sp & 255u) == 0u) { if (xb_ld(&(bar)[XB_TMO])) break; if (_sp > XB_SPIN_CAP) { atomicAdd(&(bar)[XB_TMO], 1u); break; } } } } while (0)

struct XcdBarrier {
    unsigned* bar; unsigned x;
    volatile LAS unsigned* st;
};

__device__ __forceinline__ XcdBarrier xcd_barrier_post(unsigned* bar, volatile LAS unsigned* st) {
    XcdBarrier b; b.bar = bar; b.x = xb_xcc_id(); b.st = st;
    if (threadIdx.x == 0) (void)xb_add(&bar[XB_XCNT(b.x)], 1u);
    return b;
}
__device__ __forceinline__ void xcd_barrier_complete(unsigned* bar, unsigned x, unsigned& nloc, unsigned& nx) {
    const unsigned G = gridDim.x * gridDim.y * gridDim.z;
    unsigned sum, cnt, mine, sp = 0u;
    for (;;) {
        sum = 0u; cnt = 0u; mine = 0u;
#pragma unroll
        for (unsigned j = 0; j < 16; ++j) { const unsigned c = xb_ld(&bar[XB_XCNT(j)]); sum += c; cnt += (c > 0u) ? 1u : 0u; mine = (j == x) ? c : mine; }
        if (sum == G) break;
        __builtin_amdgcn_s_sleep(1);
        if ((++sp & 255u) == 0u) { if (xb_ld(&bar[XB_TMO])) break; if (sp > XB_SPIN_CAP) { atomicAdd(&bar[XB_TMO], 1u); break; } }
    }
    nloc = mine > 0u ? mine : 1u; nx = cnt > 0u ? cnt : 1u;
}

__device__ __forceinline__ void xcd_barrier(const XcdBarrier& b) {
    asm volatile("s_waitcnt vmcnt(0)" ::: "memory");
    __syncthreads();
    if (threadIdx.x == 0) {
        unsigned* bar = b.bar;
        __builtin_amdgcn_s_waitcnt(0);
        unsigned nloc = b.st[0], nx = b.st[1];
        if (nloc == 0u) { xcd_barrier_complete(bar, b.x, nloc, nx); b.st[0] = nloc; b.st[1] = nx; }
        const unsigned old = xb_add(&bar[XB_XSUB(b.x)], 1u);
        const unsigned gen = old / nloc;
        if (old + 1u == (gen + 1u) * nloc) {
            __builtin_amdgcn_fence(__ATOMIC_RELEASE, "agent");
            asm volatile("s_waitcnt vmcnt(0)" ::: "memory");
            const unsigned og = xb_add(&bar[XB_TOP], 1u);
            const unsigned tg = og / nx;
            if (og + 1u == (tg + 1u) * nx) xb_add(&bar[XB_TOPGEN], 1u);
            else XB_SPIN(xb_ld(&bar[XB_TOPGEN]) == tg, bar);
            __builtin_amdgcn_fence(__ATOMIC_ACQUIRE, "agent");
            xb_add(&bar[XB_XGEN(b.x)], 1u);
            asm volatile("s_waitcnt vmcnt(0)" ::: "memory");
        } else {
            XB_SPIN(xb_ld(&bar[XB_XGEN(b.x)]) == gen, bar);
            __builtin_amdgcn_fence(__ATOMIC_ACQUIRE, "agent");
            asm volatile("s_waitcnt vmcnt(0)" ::: "memory");
        }
    }
    __syncthreads();
}


__global__ void __launch_bounds__(NTHREADS, 2) hymba_fwd(Params p) {
    extern __shared__ __attribute__((aligned(16))) unsigned char shm[];
    cg::grid_group grid = cg::this_grid();
    unsigned char* ws = p.ws; const int G = (int)gridDim.x;
    volatile LAS unsigned* xst = (volatile LAS unsigned*)((PG8_LAS unsigned char*)shm + (LDS_BYTES - 16));
    if (threadIdx.x == 0) { xst[0] = 0u; xst[1] = 0u; }
    __syncthreads();
    const XcdBarrier xb = xcd_barrier_post((unsigned*)(ws + WS_BAR), xst);
#ifdef PROBE_A
    unsigned long long tsv[20]; int tsn = 0;
#define TSTAMP() do { tsv[tsn++] = wall_clock64(); } while (0)
#else
#define TSTAMP() do {} while (0)
#endif
    TSTAMP();
#ifdef EXP_EMPTYPHASE
    grid.sync(); TSTAMP();
    grid.sync(); TSTAMP();
#endif
    phase_prep(p);
    if (p.ws == nullptr) grid.sync();
    xcd_barrier(xb); TSTAMP();
    { pg8::Gemm g{(const bf16_t*)p.out, (const bf16_t*)(ws + WS_WIN), M1, 2560, 1024, 1024, 1024}; pg8::StaticOrder S; S.init(g.M, g.N, G, (int)blockIdx.x);
      pg8::EpiProj E{(bf16_t*)(ws + WS_PROJ), p.out + O_KWP, p.out + O_VWP, p.out + O_KWS, p.out + O_VWS};
      pg8::gemm_phase<pg8::EpiProj, pg8::StaticOrder, false>((PG8_LAS unsigned char*)shm, g, S, E, nullptr); }
    xcd_barrier(xb); TSTAMP();
    {
        unsigned* qctr = (unsigned*)(ws + WS_BAR); volatile LAS int* qslot = (volatile LAS int*)((PG8_LAS unsigned char*)shm + (LDS_BYTES - 32));
#pragma unroll 1
        for (;;) { if (threadIdx.x == 0) *qslot = (int)atomicAdd(qctr, 1u); __syncthreads(); const int q = __builtin_amdgcn_readfirstlane(*qslot); __syncthreads(); if (q >= 928) break;
            if (q < 544) rwkv_prep_unit(p, q); else attn_item(p, q - 544); }
    }
    xcd_barrier(xb); TSTAMP();
    { ChunkRaw raw; if ((int)blockIdx.x < 2048) chunk_load(p, blockIdx.x, raw);
#ifdef PROBE_CH
      unsigned long long cht[5] = {0, 0, 0, 0, 0}; unsigned long long chl = wall_clock64();
      for (int it = blockIdx.x; it < 2048; it += G) chunk_item(p, it, it + G, raw, cht, chl);
      tsv[16] = 0; tsv[17] = cht[PROBE_CH]; tsv[18] = 0; tsv[19] = cht[PROBE_CH2];
#else
      for (int it = blockIdx.x; it < 2048; it += G) chunk_item(p, it, it + G, raw);
#endif
    }
    xcd_barrier(xb); TSTAMP();
    phase_prop(p);
    xcd_barrier(xb); TSTAMP();
    phase_out(p);
    xcd_barrier(xb); TSTAMP();
    const int cB = (int)blockIdx.x;
    {
        pg8::Gemm g{(const bf16_t*)p.out, (const bf16_t*)(ws + WS_WOUT), NP, 1024, 1024, 1024, 1024}; pg8::StaticOrder S; S.init(g.M, g.N, G, cB);
        pg8::EpiRes<true> E{p.in[I_XP], p.in[I_XS], (float*)(ws + WS_X1), (bf16_t*)(ws + WS_X1B), (float*)(ws + WS_SS1), 0};
        pg8::gemm_phase<pg8::EpiRes<true>, pg8::StaticOrder, false>((PG8_LAS unsigned char*)shm, g, S, E, nullptr); }
    {
        pg8::Gemm g{(const bf16_t*)p.out + (size_t)NP * 1024, (const bf16_t*)(ws + WS_WOUT), 1024, 1024, 1024, 1024, 1024}; pg8::StaticOrder S; S.init(g.M, g.N, G, cB);
        pg8::EpiRes<true> E{p.in[I_XP], p.in[I_XS], (float*)(ws + WS_X1), (bf16_t*)(ws + WS_X1B), (float*)(ws + WS_SS1), NP};
        pg8::gemm_phase<pg8::EpiRes<true>, pg8::StaticOrder, false>((PG8_LAS unsigned char*)shm, g, S, E, nullptr); }
    xcd_barrier(xb); TSTAMP();
    {
        pg8::Gemm g{(const bf16_t*)(ws + WS_X1B), (const bf16_t*)(ws + WS_WGU), NP, 5632, 1024, 1024, 1024}; pg8::StaticOrder S; S.init(g.M, g.N, G, cB);
        pg8::EpiAct E{(bf16_t*)(ws + WS_ACT), (const float*)(ws + WS_SS1), 0};
        pg8::gemm_phase<pg8::EpiAct, pg8::StaticOrder, false>((PG8_LAS unsigned char*)shm, g, S, E, nullptr); }
    {
        pg8::Gemm g{(const bf16_t*)(ws + WS_X1B) + (size_t)NP * 1024, (const bf16_t*)(ws + WS_WGU), 1024, 5632, 1024, 1024, 1024}; pg8::StaticOrder S; S.init(g.M, g.N, G, (cB + G / 2) % G);
        pg8::EpiAct E{(bf16_t*)(ws + WS_ACT), (const float*)(ws + WS_SS1), NP};
        pg8::gemm_phase<pg8::EpiAct, pg8::StaticOrder, false>((PG8_LAS unsigned char*)shm, g, S, E, nullptr); }
    xcd_barrier(xb); TSTAMP();
    {
        pg8::Gemm g{(const bf16_t*)(ws + WS_ACT), (const bf16_t*)(ws + WS_WD), NP, 1024, 2816, 2816, 2816}; pg8::StaticOrder S; S.init(g.M, g.N, G, cB);
        pg8::EpiRes<false> E{nullptr, nullptr, (float*)(ws + WS_X1), (bf16_t*)(ws + WS_X1B), nullptr, 0};
        pg8::gemm_phase<pg8::EpiRes<false>, pg8::StaticOrder, false>((PG8_LAS unsigned char*)shm, g, S, E, nullptr); }
#pragma unroll 1
    for (int sl = 0; sl < 4; ++sl) {
        const int kofs = sl < 2 ? 768 * sl : 1536 + 640 * (sl - 2), ks = sl < 2 ? 768 : 640;
        pg8::Gemm g{(const bf16_t*)(ws + WS_ACT) + (size_t)NP * 2816 + kofs, (const bf16_t*)(ws + WS_WD) + kofs, 1024, 1024, ks, 2816, 2816}; pg8::StaticOrder S; S.init(g.M, g.N, G, (cB + G - (G / 4) * sl) % G);
        pg8::EpiPart E{(float*)(ws + WS_PART) + (size_t)sl * 1048576};
        pg8::gemm_phase<pg8::EpiPart, pg8::StaticOrder, false>((PG8_LAS unsigned char*)shm, g, S, E, nullptr); }
    xcd_barrier(xb); TSTAMP();
    phase_final(p);
#ifdef PROBE_A
    xcd_barrier(xb); TSTAMP();
    if (blockIdx.x == 0) { __syncthreads();
        const float dA = (float)(tsv[PROBE_A + 1] - tsv[PROBE_A]) * 0.01f, dB = (float)(tsv[PROBE_B + 1] - tsv[PROBE_B]) * 0.01f;
#ifdef EXP_BIGSCALE
        for (int i = threadIdx.x; i < 2048; i += NTHREADS) p.out[O_HP + i] += floorf(dA * 0.25f) * 4.0f * 0.1f;
#else
        for (int i = threadIdx.x; i < 2048; i += NTHREADS) p.out[O_HP + i] += dA * 0.01f;
#endif
        if (threadIdx.x == 0) p.out[O_Y] += dB * 0.1f; }
#endif
}

extern "C" void kernel_launch(void* const* d_in, const int* in_sizes, int n_in, void* d_out, int out_size, void* d_ws, size_t ws_size, hipStream_t stream) {
    static int grid_blocks = 0;
    if (!grid_blocks) {
        int dev = 0, cus = 0, per_cu = 0;
        (void)hipGetDevice(&dev); (void)hipDeviceGetAttribute(&cus, hipDeviceAttributeMultiprocessorCount, dev);
        (void)hipFuncSetAttribute((const void*)hymba_fwd, hipFuncAttributeMaxDynamicSharedMemorySize, LDS_BYTES);
        (void)hipOccupancyMaxActiveBlocksPerMultiprocessor(&per_cu, (const void*)hymba_fwd, NTHREADS, LDS_BYTES);
        if (per_cu < 1) { fprintf(stderr, "kernel_launch: occupancy query says %d blocks/CU\n", per_cu); per_cu = 1; }
        if (per_cu > 1) per_cu = 1;
        grid_blocks = cus * per_cu;
        (void)hipGetLastError();
    }
    (void)hipMemsetAsync((char*)d_ws + WS_BAR, 0, XCD_BAR_WORDS * 4, stream);
    Params p{};
    for (int i = 0; i < 26; ++i) p.in[i] = (const float*)d_in[i];
    p.out = (float*)d_out; p.ws = (unsigned char*)d_ws;
    void* args[] = {&p};
    hipError_t e = hipLaunchCooperativeKernel((const void*)hymba_fwd, dim3(grid_blocks), dim3(NTHREADS), args, LDS_BYTES, stream);
    if (e != hipSuccess) fprintf(stderr, "cooperative launch failed: %s (grid %d)\n", hipGetErrorString(e), grid_blocks);
}
```

```cpp
#include <hip/hip_runtime.h>
#include <hip/hip_cooperative_groups.h>
#include <cstdio>
namespace cg = cooperative_groups;
namespace pg8 {
#define PG8_LAS __attribute__((address_space(3)))
typedef unsigned short bf16_t;
typedef short bf16x8 __attribute__((ext_vector_type(8)));
typedef float f32x4 __attribute__((ext_vector_type(4)));
typedef unsigned u32x4 __attribute__((ext_vector_type(4)));
constexpr int BM = 256, BK = 64, HALF = 128, HTB = HALF * BK * 2  , STAGE_BYTES = 8 * HTB, NXCD = 8, WGM = 8;

__host__ __device__ __forceinline__ int lds_byte(int r, int c) { const int st = (r >> 4) * 2 + (c >> 5), rr = r & 15, cc = c & 31, ob = rr * 64 + cc * 2; return st * 1024 + (ob ^ (((ob >> 9) & 1) << 5)); }
__host__ __device__ __forceinline__ void stage_rc(int b, int& R, int& C) { const int st = b / 1024, sb = b % 1024, swz = sb ^ (((sb >> 9) & 1) << 5); R = (st >> 1) * 16 + swz / 64; C = (st & 1) * 32 + (swz % 64) / 2; }
__host__ __device__ __forceinline__ int perm32(int rho) { const int n = rho >> 4, i = rho & 15; return 8 * (i >> 2) + 4 * n + (i & 3); }

struct Unit { int pm, pn; };
struct Gemm { const bf16_t* A; const bf16_t* Bt; int M, N, K, lda, ldb; };

struct StaticOrder {
    int nM, nN, nwg, G, c;
    __host__ __device__ void init(int M, int N, int G_, int c_) { nM = M / BM; nN = N / BM; nwg = nM * nN; G = G_; c = c_; }
    __host__ __device__ bool next(int i, Unit& u) const {
        const long L = (long)i * G + c; if (L >= nwg) return false;
        int wgid = (int)L; { const int q = nwg / NXCD, r = nwg % NXCD, xcd = wgid % NXCD, off = wgid / NXCD; wgid = (xcd < r ? xcd * (q + 1) : r * (q + 1) + (xcd - r) * q) + off; }
        const int nig = WGM * nN, gid = wgid / nig, fm = gid * WGM, gsz = (nM - fm) < WGM ? (nM - fm) : WGM;
        u.pm = fm + ((wgid % nig) % gsz); u.pn = (wgid % nig) / gsz; return true;
    }
    __device__ __forceinline__ void a_ready(const Unit&) const {}
    __device__ __forceinline__ void done(const Unit&) const {}
};
__device__ __forceinline__ unsigned cvt_pk_bf16(float lo, float hi) { unsigned r; asm volatile("v_cvt_pk_bf16_f32 %0, %1, %2" : "=v"(r) : "v"(lo), "v"(hi)); return r; }
struct EpiProj {
    static constexpr bool PERM = true, AFTER_DRAIN = false;
    bf16_t* O; float* kwp; float* vwp; float* kws; float* vws;
    __device__ __forceinline__ void operator()(const f32x4 (&acc)[2][2][4][2], const Unit& u, int wr, int wc, int fr, int fq) const {
        const int row0 = u.pm * BM + wr * 64 + fr; const int col0 = u.pn * BM + wc * 32 + 8 * fq;
#pragma unroll
        for (int ai = 0; ai < 2; ++ai)
#pragma unroll
            for (int m = 0; m < 4; ++m) { const int row = row0 + ai * HALF + m * 16; bf16_t* rowp = O + (size_t)row * 2560 + col0;
#pragma unroll
                for (int bj = 0; bj < 2; ++bj) { const f32x4 v0 = acc[ai][bj][m][0], v1 = acc[ai][bj][m][1];
                    u32x4 w; w.x = cvt_pk_bf16(v0[0], v0[1]); w.y = cvt_pk_bf16(v0[2], v0[3]); w.z = cvt_pk_bf16(v1[0], v1[1]); w.w = cvt_pk_bf16(v1[2], v1[3]);
                    *(u32x4*)(rowp + bj * HALF) = w; }
                if (u.pn == 2) {
                    int off = -1; bool smp = false;
                    if (row < 16384) { const int t = row & 8191; if (t >= 8064) off = (((row >> 13) * 128) + (t - 8064)) * 128; }
                    else if (row < 17408) { const int s = row - 16384; off = (((s >> 3) * 128) + 120 + (s & 7)) * 128; smp = true; }
                    if (off >= 0) {
#pragma unroll
                        for (int bj = 0; bj < 2; ++bj) { float* d = (smp ? (bj ? vws : kws) : (bj ? vwp : kwp)) + off + wc * 32 + 8 * fq;
                            *(f32x4*)d = acc[ai][bj][m][0]; *(f32x4*)(d + 4) = acc[ai][bj][m][1]; }
                    }
                }
            }
    }
};
template <bool FIRST> struct EpiRes {
    static constexpr bool PERM = false, AFTER_DRAIN = false;
    const float* xin; const float* xin2; float* X; bf16_t* XB; float* ss; int row0_;
    __device__ __forceinline__ void operator()(const f32x4 (&acc)[2][2][4][2], const Unit& u, int wr, int wc, int fr, int fq) const {
        const int row0 = row0_ + u.pm * BM + wr * 64 + fr, col0 = u.pn * BM + wc * 32 + 4 * fq;
#pragma unroll
        for (int ai = 0; ai < 2; ++ai)
#pragma unroll
            for (int m = 0; m < 4; ++m) { const int row = row0 + ai * HALF + m * 16;
                if (FIRST) { const float* xr = row < 16384 ? xin + (size_t)row * 1024 : xin2 + (size_t)(row - 16384) * 1024; float sq = 0.f;
#pragma unroll
                    for (int bj = 0; bj < 2; ++bj)
#pragma unroll
                        for (int n = 0; n < 2; ++n) { const int c = col0 + bj * HALF + n * 16; const f32x4 v = acc[ai][bj][m][n] + *(const f32x4*)(xr + c); sq += v[0] * v[0] + v[1] * v[1] + v[2] * v[2] + v[3] * v[3];
                            uint2 w; w.x = cvt_pk_bf16(v[0], v[1]); w.y = cvt_pk_bf16(v[2], v[3]); *(uint2*)(XB + (size_t)row * 1024 + c) = w; }
                    sq += __shfl_xor(sq, 16); sq += __shfl_xor(sq, 32); if (fq == 0) atomicAdd(ss + row, sq); }
                else {
#pragma unroll
                    for (int bj = 0; bj < 2; ++bj)
#pragma unroll
                        for (int n = 0; n < 2; ++n) { const int c = col0 + bj * HALF + n * 16; const uint2 xb = *(const uint2*)(XB + (size_t)row * 1024 + c);
                            f32x4 v = acc[ai][bj][m][n]; v[0] += __uint_as_float(xb.x << 16); v[1] += __uint_as_float(xb.x & 0xffff0000u); v[2] += __uint_as_float(xb.y << 16); v[3] += __uint_as_float(xb.y & 0xffff0000u);
                            uint2 w; w.x = cvt_pk_bf16(v[0], v[1]); w.y = cvt_pk_bf16(v[2], v[3]); *(uint2*)(XB + (size_t)row * 1024 + c) = w; } }
            }
    }
};
struct EpiAct {
    static constexpr bool PERM = true, AFTER_DRAIN = false;
    bf16_t* ACT; const float* ss; int row0_;
    __device__ __forceinline__ void operator()(const f32x4 (&acc)[2][2][4][2], const Unit& u, int wr, int wc, int fr, int fq) const {
        const int row0 = row0_ + u.pm * BM + wr * 64 + fr, col0 = u.pn * 128 + wc * 32 + 8 * fq;
#pragma unroll
        for (int ai = 0; ai < 2; ++ai)
#pragma unroll
            for (int m = 0; m < 4; ++m) { const int row = row0 + ai * HALF + m * 16; const float rstd = rsqrtf(ss[row] * (1.0f / 1024.0f) + 1e-6f);
                float a[8];
#pragma unroll
                for (int n = 0; n < 2; ++n)
#pragma unroll
                    for (int j = 0; j < 4; ++j) { const float g = acc[ai][0][m][n][j] * rstd, up = acc[ai][1][m][n][j] * rstd; a[4 * n + j] = g * __builtin_amdgcn_rcpf(1.0f + __expf(-g)) * up; }
                u32x4 w; w.x = cvt_pk_bf16(a[0], a[1]); w.y = cvt_pk_bf16(a[2], a[3]); w.z = cvt_pk_bf16(a[4], a[5]); w.w = cvt_pk_bf16(a[6], a[7]);
                *(u32x4*)(ACT + (size_t)row * 2816 + col0) = w; }
    }
};
struct EpiPart {
    static constexpr bool PERM = false, AFTER_DRAIN = false;
    float* P;
    __device__ __forceinline__ void operator()(const f32x4 (&acc)[2][2][4][2], const Unit& u, int wr, int wc, int fr, int fq) const {
        const int row0 = u.pm * BM + wr * 64 + fr, col0 = u.pn * BM + wc * 32 + 4 * fq;
#pragma unroll
        for (int ai = 0; ai < 2; ++ai)
#pragma unroll
            for (int m = 0; m < 4; ++m) { float* rowp = P + (size_t)(row0 + ai * HALF + m * 16) * 1024 + col0;
#pragma unroll
                for (int bj = 0; bj < 2; ++bj)
#pragma unroll
                    for (int n = 0; n < 2; ++n) *(f32x4*)(rowp + bj * HALF + n * 16) = acc[ai][bj][m][n]; }
    }
};

template <class Epi, class Sched, bool STAMP = false>
__device__ __forceinline__ void gemm_phase(PG8_LAS unsigned char* lds, const Gemm g, const Sched& S, const Epi& E, unsigned long long* stamps) {
    const int tid = threadIdx.x, wid = __builtin_amdgcn_readfirstlane(tid >> 6), lane = tid & 63, wr = wid >> 2, wc = wid & 3, fr = lane & 15, fq = lane >> 4;
    const int K = g.K, nt = K / BK;
    int ts_lo = 0, ts_hi = 0, nts = 0; const unsigned long long rt_entry = STAMP ? (unsigned long long)wall_clock64() : 0ull;
#define PG8_STAMP() do { if (STAMP && wid == 0 && nts < 64) { const unsigned long long _c = (unsigned long long)clock64(); \
        ts_lo = (lane == nts) ? (int)(unsigned)_c : ts_lo; ts_hi = (lane == nts) ? (int)(unsigned)(_c >> 32) : ts_hi; ++nts; } } while (0)
    PG8_STAMP();
    unsigned voffA[2], voffB[2];
#pragma unroll
    for (int i = 0; i < 2; ++i) { int R, C; stage_rc(tid * 16 + i * 8192, R, C); const int Rb = Epi::PERM ? ((R & ~31) + perm32(R & 31)) : R;
        voffA[i] = (unsigned)(R * g.lda + C) * 2u; voffB[i] = (unsigned)(Rb * g.ldb + C) * 2u; }
    const size_t kstep = (size_t)(BK * 2);
    const size_t hstepA = (size_t)HALF * g.lda * 2, hstepB = (size_t)HALF * g.ldb * 2;
    const size_t tstepA = 2 * hstepA, tstepB = 2 * hstepB;
    const unsigned ldsw = (unsigned)wid * 1024u;
    const int aoff = lds_byte(wr * 64 + fr, fq * 8), boff = lds_byte(wc * 32 + fr, fq * 8);
#define PG8_SA(b, h) (((b) * 2 + (h)) * HTB)
#define PG8_SB(b, h) ((4 + (b) * 2 + (h)) * HTB)
#define PG8_STAGE(bufoff, gbase, voff) do { _Pragma("unroll") for (int _i = 0; _i < 2; ++_i) \
        __builtin_amdgcn_global_load_lds((const unsigned*)((const char*)(gbase) + (voff)[_i]), (PG8_LAS unsigned*)(lds + (bufoff) + ldsw + _i * 8192), 16, 0, 0); } while (0)
#define PG8_LDA(dst, b, h) do { _Pragma("unroll") for (int m = 0; m < 4; ++m) _Pragma("unroll") for (int k = 0; k < 2; ++k) dst[m][k] = *(const PG8_LAS bf16x8*)(lds + PG8_SA(b, h) + aoff + m * 2048 + k * 1024); } while (0)
#define PG8_LDB(dst, b, h) do { _Pragma("unroll") for (int n = 0; n < 2; ++n) _Pragma("unroll") for (int k = 0; k < 2; ++k) dst[n][k] = *(const PG8_LAS bf16x8*)(lds + PG8_SB(b, h) + boff + n * 2048 + k * 1024); } while (0)
#define PG8_MMA(ai, bj, At, Bt) do { __builtin_amdgcn_s_setprio(1); _Pragma("unroll") for (int m = 0; m < 4; ++m) _Pragma("unroll") for (int n = 0; n < 2; ++n) _Pragma("unroll") for (int k = 0; k < 2; ++k) \
        acc[ai][bj][m][n] = __builtin_amdgcn_mfma_f32_16x16x32_bf16(Bt[n][k], At[m][k], acc[ai][bj][m][n], 0, 0, 0); __builtin_amdgcn_s_setprio(0); } while (0)
#define PG8_WAIT_V(n) asm volatile("s_waitcnt vmcnt(" #n ")" ::: "memory")
#define PG8_WAIT_L(n) asm volatile("s_waitcnt lgkmcnt(" #n ")" ::: "memory")
#define PG8_BAR __builtin_amdgcn_s_barrier()
#define PG8_SCHED __builtin_amdgcn_sched_barrier(0)
    Unit cur, nxt; int ui = 0;
    if (!S.next(0, cur)) return;
    f32x4 acc[2][2][4][2];
#pragma unroll
    for (int a = 0; a < 2; ++a)
#pragma unroll
        for (int b = 0; b < 2; ++b)
#pragma unroll
            for (int m = 0; m < 4; ++m)
#pragma unroll
                for (int n = 0; n < 2; ++n) acc[a][b][m][n] = (f32x4){0.f, 0.f, 0.f, 0.f};
    bf16x8 At[4][2], B0[2][2], B1[2][2];
    const char* cA = (const char*)g.A + (size_t)cur.pm * tstepA; const char* cB = (const char*)g.Bt + (size_t)cur.pn * tstepB;
    S.a_ready(cur);
    PG8_STAGE(PG8_SB(0, 0), cB, voffB); PG8_STAGE(PG8_SA(0, 0), cA, voffA); PG8_STAGE(PG8_SB(0, 1), cB + hstepB, voffB); PG8_STAGE(PG8_SA(0, 1), cA + hstepA, voffA);
    if (wr == 1) PG8_BAR;
    PG8_WAIT_V(4); PG8_BAR;
    PG8_STAGE(PG8_SB(1, 0), cB + kstep, voffB); PG8_STAGE(PG8_SA(1, 0), cA + kstep, voffA); PG8_STAGE(PG8_SB(1, 1), cB + hstepB + kstep, voffB);
    PG8_WAIT_V(6); PG8_BAR;
    PG8_STAMP();
    for (;;) {
        const bool has_next = S.next(ui + 1, nxt);
        const char* nA = has_next ? (const char*)g.A + (size_t)nxt.pm * tstepA : cA; const char* nB = has_next ? (const char*)g.Bt + (size_t)nxt.pn * tstepB : cB;
        for (int t = 0; t < nt; t += 2) {
            const bool last = (t == nt - 2);
            const char* a1 = cA + (size_t)(t + 1) * kstep;
            const char* a2 = last ? nA : cA + (size_t)(t + 2) * kstep; const char* b2 = last ? nB : cB + (size_t)(t + 2) * kstep;
            const char* a3 = a2 + kstep; const char* b3 = b2 + kstep;
            if (last && has_next) S.a_ready(nxt);
            PG8_LDB(B0, 0, 0); PG8_SCHED; PG8_LDA(At, 0, 0); PG8_STAGE(PG8_SA(1, 1), a1 + hstepA, voffA);
            PG8_WAIT_L(8); PG8_BAR; PG8_WAIT_L(0); PG8_MMA(0, 0, At, B0); PG8_BAR; PG8_SCHED;
            PG8_LDB(B1, 0, 1); PG8_STAGE(PG8_SB(0, 0), b2, voffB);
            PG8_BAR; PG8_WAIT_L(0); PG8_MMA(0, 1, At, B1); PG8_BAR;
            PG8_LDA(At, 0, 1); PG8_STAGE(PG8_SA(0, 0), a2, voffA);
            PG8_BAR; PG8_WAIT_L(0); PG8_MMA(1, 0, At, B0); PG8_BAR; PG8_SCHED;
            PG8_STAGE(PG8_SB(0, 1), b2 + hstepB, voffB);
            PG8_WAIT_V(6); PG8_BAR; PG8_MMA(1, 1, At, B1); PG8_BAR;
            PG8_LDB(B0, 1, 0); PG8_SCHED; PG8_LDA(At, 1, 0); PG8_STAGE(PG8_SA(0, 1), a2 + hstepA, voffA);
            PG8_WAIT_L(8); PG8_BAR; PG8_WAIT_L(0); PG8_MMA(0, 0, At, B0); PG8_BAR; PG8_SCHED;
            PG8_LDB(B1, 1, 1); PG8_STAGE(PG8_SB(1, 0), b3, voffB);
            PG8_BAR; PG8_WAIT_L(0); PG8_MMA(0, 1, At, B1); PG8_BAR;
            PG8_LDA(At, 1, 1); PG8_STAGE(PG8_SA(1, 0), a3, voffA);
            PG8_BAR; PG8_WAIT_L(0); PG8_MMA(1, 0, At, B0); PG8_BAR; PG8_SCHED;
            PG8_STAGE(PG8_SB(1, 1), b3 + hstepB, voffB);
            PG8_WAIT_V(6); PG8_BAR; PG8_MMA(1, 1, At, B1); PG8_BAR;
        }
        PG8_STAMP();
        if constexpr (!Epi::AFTER_DRAIN) { E(acc, cur, wr, wc, fr, fq); S.done(cur); }
        PG8_STAMP();
        if (!has_next) break;
#pragma unroll
        for (int a = 0; a < 2; ++a)
#pragma unroll
            for (int b = 0; b < 2; ++b)
#pragma unroll
                for (int m = 0; m < 4; ++m)
#pragma unroll
                    for (int n = 0; n < 2; ++n) acc[a][b][m][n] = (f32x4){0.f, 0.f, 0.f, 0.f};
        cur = nxt; cA = nA; cB = nB; ++ui;
    }
    PG8_WAIT_V(0);
    if (wr == 0) PG8_BAR;
    PG8_BAR;
    if constexpr (Epi::AFTER_DRAIN) { E.fused(acc, cur, wr, wc, fr, fq, lds, wid, lane); S.done(cur); }
    PG8_STAMP();
    if (STAMP && wid == 0) { stamps[lane] = lane < nts ? (((unsigned long long)(unsigned)ts_hi << 32) | (unsigned)ts_lo) : 0ull;
        if (lane == 62) stamps[62] = rt_entry; if (lane == 63) stamps[63] = (unsigned long long)wall_clock64(); }
#undef PG8_STAMP
#undef PG8_SA
#undef PG8_SB
#undef PG8_STAGE
#undef PG8_LDA
#undef PG8_LDB
#undef PG8_MMA
#undef PG8_WAIT_V
#undef PG8_WAIT_L
#undef PG8_BAR
#undef PG8_SCHED
}
}
#define DI __device__ __forceinline__
typedef unsigned short bf16_t;
typedef short bf16x8 __attribute__((ext_vector_type(8)));
typedef short s16x4 __attribute__((ext_vector_type(4)));
typedef float f32x4 __attribute__((ext_vector_type(4)));
typedef float f32x16 __attribute__((ext_vector_type(16)));
typedef unsigned u32x4 __attribute__((ext_vector_type(4)));
typedef float f32x2v __attribute__((ext_vector_type(2)));
typedef __bf16 bf2v __attribute__((ext_vector_type(2)));
#define MFMA32(a, b, c) __builtin_amdgcn_mfma_f32_32x32x16_bf16((a), (b), (c), 0, 0, 0)
#define MFMA16(a, b, c) __builtin_amdgcn_mfma_f32_16x16x32_bf16((a), (b), (c), 0, 0, 0)

constexpr int NP = 16384, NTOK = 17408, M1 = 17664, LDS_BYTES = 147456, NTHREADS = 512;
constexpr size_t WS_WIN = 0, WS_WOUT = 5242880, WS_WGU = 7340032, WS_WD = 18874368, WS_W2T = 24641536, WS_A2T = WS_W2T + 65536, WS_G2T = WS_A2T + 65536,
    WS_SS1 = 24903680, WS_SS2 = WS_SS1 + 69632, WS_BONUS = 25042944, WS_PROJ = 25600000, WS_RW = 116039680, RWB = 17825792  ,
    WS_R = WS_RW, WS_K = WS_RW + RWB, WS_V = WS_RW + 2 * RWB, WS_A = WS_RW + 3 * RWB, WS_B = WS_RW + 4 * RWB, WS_G = WS_RW + 5 * RWB, WS_W = WS_RW + 6 * RWB,
    WS_MT = WS_PROJ, WS_N = WS_PROJ + 16777216, WS_QT = WS_PROJ + 50331648, WS_SC = WS_PROJ + 67108864,
    WS_PART = 230596608, WS_BAR = 258646016,
    WS_X1 = 25600000, WS_X1B = 96903168, WS_ACT = 132554752;
constexpr size_t O_Y = 0, O_KWP = 17825792, O_VWP = O_KWP + 32768, O_SP = O_VWP + 32768, O_HP = O_SP + 65536, O_KWS = O_HP + 2048, O_VWS = O_KWS + 2097152, O_SS = O_VWS + 2097152, O_HS = O_SS + 4194304;

struct Params { const float* in[26]; float* out; unsigned char* ws; };
enum { I_XP = 0, I_XS, I_CK, I_CV, I_SW, I_SH, I_GMIX, I_WIN, I_SINK, I_MU, I_W0, I_W2, I_A0, I_A2, I_G2, I_KK, I_KA, I_RK, I_GNG, I_GNB, I_WOUT, I_GFFN, I_WG, I_WU, I_WD, I_GFIN };

DI int opaque_tid() { int t = threadIdx.x; asm volatile("" : "+v"(t)); return t; }
DI unsigned pk2(float a, float b) { f32x2v v = {a, b}; return __builtin_bit_cast(unsigned, __builtin_convertvector(v, bf2v)); }
DI unsigned pk2a(float lo, float hi) { unsigned r; asm volatile("v_cvt_pk_bf16_f32 %0, %1, %2" : "=v"(r) : "v"(lo), "v"(hi)); return r; }
DI float bflo(unsigned u) { return __uint_as_float(u << 16); }
DI float bfhi(unsigned u) { return __uint_as_float(u & 0xffff0000u); }
DI float bf1(bf16_t u) { return __uint_as_float(((unsigned)u) << 16); }
DI float sigmoidf_(float x) { return __builtin_amdgcn_rcpf(1.0f + __expf(-x)); }
DI float tanhf_(float x) { return 1.0f - 2.0f * __builtin_amdgcn_rcpf(1.0f + __expf(2.0f * x)); }
DI int prev_row(int m) {
    if (m < NP) return (m & 8191) == 0 ? -1 : m - 1;
    const int s = m - NP; return (s & 7) == 0 ? NTOK + (s >> 3) : m - 1;
}

#define LBAR0() do { asm volatile("s_waitcnt lgkmcnt(0)" ::: "memory"); __builtin_amdgcn_s_barrier(); asm volatile("" ::: "memory"); } while (0)
struct TrJob { const float* src; bf16_t* dst; const float* scale; int ldn, k0, n0, ldk, drow0; };
DI TrJob tr_decode(const Params& p, int job) {
    unsigned char* ws = p.ws; int j = job; TrJob t;
    if (j < 640) { t = TrJob{p.in[I_WIN], (bf16_t*)(ws + WS_WIN), nullptr, 2560, (j % 16) * 64, (j / 16) * 64, 1024, (j / 16) * 64}; return t; } j -= 640;
    if (j < 256) { t = TrJob{p.in[I_WOUT], (bf16_t*)(ws + WS_WOUT), nullptr, 1024, (j % 16) * 64, (j / 16) * 64, 1024, (j / 16) * 64}; return t; } j -= 256;
    if (j < 1408) { const bool up = j >= 704; if (up) j -= 704; const int n0 = (j / 16) * 64; const int dr = (n0 >> 7) * 256 + (up ? 128 : 0) + (n0 & 127);
        t = TrJob{p.in[up ? I_WU : I_WG], (bf16_t*)(ws + WS_WGU), p.in[I_GFFN], 2816, (j % 16) * 64, n0, 1024, dr}; return t; } j -= 1408;
    if (j < 704) { t = TrJob{p.in[I_WD], (bf16_t*)(ws + WS_WD), nullptr, 1024, (j % 44) * 64, (j / 44) * 64, 2816, (j / 44) * 64}; return t; } j -= 704;
    if (j < 8) { t = TrJob{p.in[I_W2], (bf16_t*)(ws + WS_W2T), nullptr, 512, 0, j * 64, 64, j * 64}; return t; } j -= 8;
    if (j < 8) { t = TrJob{p.in[I_A2], (bf16_t*)(ws + WS_A2T), nullptr, 512, 0, j * 64, 64, j * 64}; return t; } j -= 8;
    t = TrJob{p.in[I_G2], (bf16_t*)(ws + WS_G2T), nullptr, 512, (j & 1) * 64, (j >> 1) * 64, 128, (j >> 1) * 64}; return t;
}
DI void tr_load(const TrJob& t, float4& a, float4& b, float& sc) { const int tid = opaque_tid(), r = tid >> 3, c8 = (tid & 7) * 8; const float* s = t.src + (size_t)(t.k0 + r) * t.ldn + t.n0 + c8;
    a = *(const float4*)s; b = *(const float4*)(s + 4); sc = t.scale ? t.scale[t.k0 + r] : 1.f; }
DI void tr_finish(const TrJob& t, const float4& a, const float4& b, float sc) {
    extern __shared__ __attribute__((aligned(16))) unsigned char shm[]; float* T = (float*)shm;
    const int tid = opaque_tid(); { const int r = tid >> 3, c8 = (tid & 7) * 8; float* q = T + r * 65 + c8;
        q[0] = a.x * sc; q[1] = a.y * sc; q[2] = a.z * sc; q[3] = a.w * sc; q[4] = b.x * sc; q[5] = b.y * sc; q[6] = b.z * sc; q[7] = b.w * sc; }
    LBAR0();
    { const int n = tid >> 3, k8 = (tid & 7) * 8; float v[8];
#pragma unroll
        for (int j = 0; j < 8; ++j) v[j] = T[(k8 + j) * 65 + n];
        uint4 w; w.x = pk2(v[0], v[1]); w.y = pk2(v[2], v[3]); w.z = pk2(v[4], v[5]); w.w = pk2(v[6], v[7]);
        *(uint4*)(t.dst + (size_t)(t.drow0 + n) * t.ldk + t.k0 + k8) = w; }
    LBAR0();
}
DI void tr_run(const Params& p, int first, int stride, int lo, int n) {
    auto jobof = [&](int v) -> int { return lo == 0 ? (v < 640 ? v : 3008 + (v - 640)) : lo + v; };
    int v = first; if (v >= n) return; TrJob cur = tr_decode(p, jobof(v)); float4 a, b; float sc; tr_load(cur, a, b, sc);
#pragma unroll 1
    for (; v < n; v += stride) { const int nv = v + stride; const TrJob nxt = tr_decode(p, jobof(nv < n ? nv : v)); float4 a2, b2; float sc2; tr_load(nxt, a2, b2, sc2);
        tr_finish(cur, a, b, sc); cur = nxt; a = a2; b = b2; sc = sc2; }
}
DI void phase_prep(const Params& p) {
    unsigned char* ws = p.ws; const int tid = opaque_tid(), wid = tid >> 6, lane = tid & 63;
    tr_run(p, blockIdx.x, gridDim.x, 640, 2400);
    tr_run(p, blockIdx.x, gridDim.x, 0, 640);
    bf16_t* XN = (bf16_t*)p.out; const float* gm = p.in[I_GMIX];
    auto rowsrc = [&](int m) -> const float* { return m < NP ? p.in[I_XP] + (size_t)m * 1024 : (m < NTOK ? p.in[I_XS] + (size_t)(m - NP) * 1024 : p.in[I_SH] + (size_t)(m < NTOK + 128 ? m - NTOK : 0) * 1024); };
    { int m = blockIdx.x * 8 + wid; float4 v[4];
      if (m < M1) { const float* src = rowsrc(m);
#pragma unroll
          for (int i = 0; i < 4; ++i) { const f32x4 t_ = __builtin_nontemporal_load((const f32x4*)(src + lane * 4 + 256 * i)); v[i] = make_float4(t_[0], t_[1], t_[2], t_[3]); } }
#pragma unroll 1
      for (; m < M1; m += gridDim.x * 8) {
        bf16_t* dst = XN + (size_t)m * 1024; const int mn = m + gridDim.x * 8; float4 vn[4];
        if (mn < M1) { const float* src = rowsrc(mn);
#pragma unroll
            for (int i = 0; i < 4; ++i) { const f32x4 t_ = __builtin_nontemporal_load((const f32x4*)(src + lane * 4 + 256 * i)); vn[i] = make_float4(t_[0], t_[1], t_[2], t_[3]); } }
        if (m >= NTOK + 128) { for (int i = 0; i < 4; ++i) *(uint2*)(dst + lane * 4 + 256 * i) = make_uint2(0u, 0u); }
        else {
        float sq = 0.f;
#pragma unroll
        for (int i = 0; i < 4; ++i) sq += v[i].x * v[i].x + v[i].y * v[i].y + v[i].z * v[i].z + v[i].w * v[i].w;
        float rstd = 1.f; const bool norm = m < NTOK;
        if (norm) {
#pragma unroll
            for (int o = 32; o >= 1; o >>= 1) sq += __shfl_xor(sq, o);
            rstd = rsqrtf(sq * (1.0f / 1024.0f) + 1e-6f); }
        float* sh = nullptr;
        if (m < NP) { if ((m & 8191) == 8191) sh = p.out + O_HP + (size_t)(m >> 13) * 1024; } else if (m < NTOK) { const int s = m - NP; if ((s & 7) == 7) sh = p.out + O_HS + (size_t)(s >> 3) * 1024; }
#pragma unroll
        for (int i = 0; i < 4; ++i) { float4 h = v[i];
            if (norm) { const float4 g = *(const float4*)(gm + lane * 4 + 256 * i); h.x *= rstd * g.x; h.y *= rstd * g.y; h.z *= rstd * g.z; h.w *= rstd * g.w; }
            *(uint2*)(dst + lane * 4 + 256 * i) = make_uint2(pk2(h.x, h.y), pk2(h.z, h.w));
            if (sh) *(float4*)(sh + lane * 4 + 256 * i) = h; }
        }
#pragma unroll
        for (int i = 0; i < 4; ++i) v[i] = vn[i];
      } }
    const size_t gt = (size_t)blockIdx.x * NTHREADS + tid, gs = (size_t)gridDim.x * NTHREADS;
    for (int i = (int)gt; i < 2 * 128 * 3840; i += (int)gs) { const int which = i >= 128 * 3840 ? 1 : 0; const int rr = i - which * 128 * 3840; const int b = rr / 3840, q = rr - b * 3840;
        const float* s = p.in[which ? I_CV : I_CK] + (size_t)b * 16384 + 1024 + q * 4; float* d = p.out + (which ? O_VWS : O_KWS) + (size_t)b * 16384 + q * 4; *(float4*)d = *(const float4*)s; }
    for (size_t i = gt; i < (size_t)NTOK; i += gs) ((float*)(ws + WS_SS1))[i] = 0.f;
}

DI void load4bf(const bf16_t* p_, float (&o)[4]) { const uint2 u = *(const uint2*)p_; o[0] = bflo(u.x); o[1] = bfhi(u.x); o[2] = bflo(u.y); o[3] = bfhi(u.y); }
DI void xs4(const bf16_t* cp, const bf16_t* pp, float pf, const float* mu, float (&o)[4]) {
    float c[4], q[4]; load4bf(cp, c); load4bf(pp, q);
    const float4 u = *(const float4*)mu; o[0] = c[0] + (q[0] * pf - c[0]) * u.x; o[1] = c[1] + (q[1] * pf - c[1]) * u.y; o[2] = c[2] + (q[2] * pf - c[2]) * u.z; o[3] = c[3] + (q[3] * pf - c[3]) * u.w;
}
DI void rwkv_prep_unit(const Params& p, int unit) {
    extern __shared__ __attribute__((aligned(16))) unsigned char shm[]; bf16_t* XL = (bf16_t*)shm;
    unsigned char* ws = p.ws; const bf16_t* PROJ = (const bf16_t*)(ws + WS_PROJ); const float* mu = p.in[I_MU];
    const int tid = opaque_tid(), wid = tid >> 6, lane = tid & 63, r = lane & 31, hh = lane >> 5, m0 = unit * 32;
    for (int idx = tid; idx < 32 * 32; idx += NTHREADS) { const int tok = idx >> 5, c8 = (idx & 31) * 8, m = m0 + tok, pr = prev_row(m);
        const bf16_t* cp = PROJ + (size_t)m * 2560 + 768 + 1536 + c8; const bf16_t* pp = PROJ + (size_t)(pr >= 0 ? pr : m) * 2560 + 768 + 1536 + c8; const float pf = pr >= 0 ? 1.f : 0.f;
        float a[4], b[4]; xs4(cp, pp, pf, mu + 1536 + c8, a); xs4(cp + 4, pp + 4, pf, mu + 1536 + c8 + 4, b);
        if (c8 < 64) {
#pragma unroll
            for (int j = 0; j < 4; ++j) { a[j] = tanhf_(a[j]); b[j] = tanhf_(b[j]); } }
        else if (c8 >= 128) {
#pragma unroll
            for (int j = 0; j < 4; ++j) { a[j] = sigmoidf_(a[j]); b[j] = sigmoidf_(b[j]); } }
        uint4 w; w.x = pk2(a[0], a[1]); w.y = pk2(a[2], a[3]); w.z = pk2(b[0], b[1]); w.w = pk2(b[2], b[3]); *(uint4*)(XL + tok * 264 + c8) = w; }
    float* INVN = (float*)(shm + 34048);
#pragma unroll 1
    for (int idx = tid; idx < 32 * 128; idx += NTHREADS) { const int tok = idx >> 7, c4 = (idx & 127) * 4, m = m0 + tok, pr = prev_row(m); const float pf = pr >= 0 ? 1.f : 0.f;
        float k4[4]; xs4(PROJ + (size_t)m * 2560 + 768 + 512 + c4, PROJ + (size_t)(pr >= 0 ? pr : m) * 2560 + 768 + 512 + c4, pf, mu + 512 + c4, k4); const float4 kk4 = *(const float4*)(p.in[I_KK] + c4);
        const float q0 = k4[0] * kk4.x, q1 = k4[1] * kk4.y, q2 = k4[2] * kk4.z, q3 = k4[3] * kk4.w; float sq = q0 * q0 + q1 * q1 + q2 * q2 + q3 * q3;
        sq += __shfl_xor(sq, 1); sq += __shfl_xor(sq, 2); sq += __shfl_xor(sq, 4); sq += __shfl_xor(sq, 8);
        if ((lane & 15) == 0) INVN[tok * 8 + (c4 >> 6)] = rsqrtf(sq + 1e-12f); }
    __syncthreads();
    const int h = wid, c2 = h * 64 + 2 * r; const bf16_t* w2t = (const bf16_t*)(ws + WS_W2T); const bf16_t* a2t = (const bf16_t*)(ws + WS_A2T); const bf16_t* g2t = (const bf16_t*)(ws + WS_G2T);
    bf16_t* Rb = (bf16_t*)(ws + WS_R); bf16_t* Kb = (bf16_t*)(ws + WS_K); bf16_t* Vb = (bf16_t*)(ws + WS_V); bf16_t* Ab = (bf16_t*)(ws + WS_A); bf16_t* Bb = (bf16_t*)(ws + WS_B); bf16_t* Gb = (bf16_t*)(ws + WS_G);
    float* Wf = (float*)(ws + WS_W); float* BON = (float*)(ws + WS_BONUS);
    const float2 mur = *(const float2*)(mu + c2), muk = *(const float2*)(mu + 512 + c2), muv = *(const float2*)(mu + 1024 + c2), kkc = *(const float2*)(p.in[I_KK] + c2), kac = *(const float2*)(p.in[I_KA] + c2),
                 w0c = *(const float2*)(p.in[I_W0] + c2), a0c = *(const float2*)(p.in[I_A0] + c2), rkc = *(const float2*)(p.in[I_RK] + c2);
    { const int tt = 0;
        f32x16 Dw[2], Da[2], Dg[2];
#pragma unroll
        for (int ct = 0; ct < 2; ++ct)
#pragma unroll
            for (int i = 0; i < 16; ++i) { Dw[ct][i] = 0.f; Da[ct][i] = 0.f; Dg[ct][i] = 0.f; }
        const bf16_t* xrow = XL + (32 * tt + r) * 264 + 8 * hh;
        { bf16x8 wf[4][2];
#pragma unroll
            for (int s = 0; s < 4; ++s)
#pragma unroll
                for (int ct = 0; ct < 2; ++ct) wf[s][ct] = *(const bf16x8*)(w2t + (c2 + ct) * 64 + 16 * s + 8 * hh);
#pragma unroll
            for (int s = 0; s < 4; ++s) { const bf16x8 xw = *(const bf16x8*)(xrow + 16 * s);
#pragma unroll
                for (int ct = 0; ct < 2; ++ct) Dw[ct] = MFMA32(xw, wf[s][ct], Dw[ct]); } }
        __builtin_amdgcn_sched_barrier(0);
        { bf16x8 af[4][2];
#pragma unroll
            for (int s = 0; s < 4; ++s)
#pragma unroll
                for (int ct = 0; ct < 2; ++ct) af[s][ct] = *(const bf16x8*)(a2t + (c2 + ct) * 64 + 16 * s + 8 * hh);
#pragma unroll
            for (int s = 0; s < 4; ++s) { const bf16x8 xa = *(const bf16x8*)(xrow + 64 + 16 * s);
#pragma unroll
                for (int ct = 0; ct < 2; ++ct) Da[ct] = MFMA32(xa, af[s][ct], Da[ct]); } }
        __builtin_amdgcn_sched_barrier(0);
#pragma unroll
        for (int sh2 = 0; sh2 < 2; ++sh2) { bf16x8 gf[4][2];
#pragma unroll
            for (int s = 0; s < 4; ++s)
#pragma unroll
                for (int ct = 0; ct < 2; ++ct) gf[s][ct] = *(const bf16x8*)(g2t + (c2 + ct) * 128 + 64 * sh2 + 16 * s + 8 * hh);
#pragma unroll
            for (int s = 0; s < 4; ++s) { const bf16x8 xg = *(const bf16x8*)(xrow + 128 + 64 * sh2 + 16 * s);
#pragma unroll
                for (int ct = 0; ct < 2; ++ct) Dg[ct] = MFMA32(xg, gf[s][ct], Dg[ct]); }
            __builtin_amdgcn_sched_barrier(0); }
#pragma unroll
        for (int i = 0; i < 16; ++i) *(unsigned*)(Gb + (size_t)(m0 + 32 * tt + (i & 3) + 8 * (i >> 2) + 4 * hh) * 512 + c2) = pk2(Dg[0][i], Dg[1][i]);
        __builtin_amdgcn_sched_barrier(0);
        float bon[16];
#pragma unroll
        for (int i = 0; i < 16; ++i) { const int m = m0 + 32 * tt + (i & 3) + 8 * (i >> 2) + 4 * hh, pr = prev_row(m); const float pf = pr >= 0 ? 1.f : 0.f;
            const bf16_t* cp = PROJ + (size_t)m * 2560 + 768 + c2; const bf16_t* pp = PROJ + (size_t)(pr >= 0 ? pr : m) * 2560 + 768 + c2;
            const unsigned urc = *(const unsigned*)cp, ukc = *(const unsigned*)(cp + 512), uvc = *(const unsigned*)(cp + 1024), urp = *(const unsigned*)pp, ukp = *(const unsigned*)(pp + 512), uvp = *(const unsigned*)(pp + 1024);
            const float inv = INVN[(32 * tt + (i & 3) + 8 * (i >> 2) + 4 * hh) * 8 + h];
            float rr[2], kx[2], vx[2], dec[2], km[2], an[2], bn[2];
            { float c; c = bflo(urc); rr[0] = c + (bflo(urp) * pf - c) * mur.x; c = bfhi(urc); rr[1] = c + (bfhi(urp) * pf - c) * mur.y;
              c = bflo(ukc); kx[0] = c + (bflo(ukp) * pf - c) * muk.x; c = bfhi(ukc); kx[1] = c + (bfhi(ukp) * pf - c) * muk.y;
              c = bflo(uvc); vx[0] = c + (bflo(uvp) * pf - c) * muv.x; c = bfhi(uvc); vx[1] = c + (bfhi(uvp) * pf - c) * muv.y; }
            const float kk2[2] = {kkc.x, kkc.y}, ka2[2] = {kac.x, kac.y}, w02[2] = {w0c.x, w0c.y}, a02[2] = {a0c.x, a0c.y}, rk2[2] = {rkc.x, rkc.y};
            float bsum = 0.f;
#pragma unroll
            for (int ct = 0; ct < 2; ++ct) { const float x = -(w02[ct] + Dw[ct][i]); const float sp = fmaxf(x, 0.f) + 0.69314718f * __builtin_amdgcn_logf(1.0f + __expf(-fabsf(x))); dec[ct] = -__expf(-sp - 0.5f);
                const float as = sigmoidf_(a02[ct] + Da[ct][i]); const float kkn = kx[ct] * kk2[ct] * inv; km[ct] = kx[ct] * (1.0f + (as - 1.0f) * ka2[ct]); an[ct] = -kkn; bn[ct] = kkn * as; bsum += rr[ct] * km[ct] * rk2[ct]; }
            bon[i] = bsum; const size_t o = (size_t)m * 512 + c2;
            *(unsigned*)(Rb + o) = pk2(rr[0], rr[1]); *(unsigned*)(Kb + o) = pk2(km[0], km[1]); *(unsigned*)(Vb + o) = pk2(vx[0], vx[1]); *(unsigned*)(Ab + o) = pk2(an[0], an[1]); *(unsigned*)(Bb + o) = pk2(bn[0], bn[1]);
            *(float2*)(Wf + o) = make_float2(dec[0], dec[1]);
            if ((i & 3) == 3) __builtin_amdgcn_sched_barrier(0); }
    #pragma unroll
        for (int o = 1; o < 32; o <<= 1)
#pragma unroll
            for (int i = 0; i < 16; ++i) bon[i] += __shfl_xor(bon[i], o);
        if (r == 0) {
#pragma unroll
            for (int i = 0; i < 16; ++i) BON[(size_t)(m0 + 32 * tt + (i & 3) + 8 * (i >> 2) + 4 * hh) * 8 + h] = bon[i]; }
    }
    __syncthreads();
}

DI void attn_wave_tile(const bf16_t* Ks, const bf16_t* Vt, int j0, const bf16_t* qptr, int lo, int hi, float sink, bf16_t* optr) {
    const int lane = opaque_tid() & 63, r = lane & 31, hh = lane >> 5;
    bf16x8 qf[4];
#pragma unroll
    for (int s = 0; s < 4; ++s) qf[s] = *(const bf16x8*)(qptr + 16 * s + 8 * hh);
    f32x16 sc[5];
#pragma unroll
    for (int kt = 0; kt < 5; ++kt) {
#pragma unroll
        for (int i = 0; i < 16; ++i) sc[kt][i] = 0.f;
#pragma unroll
        for (int s = 0; s < 4; ++s) sc[kt] = MFMA32(*(const bf16x8*)(Ks + (j0 + 32 * kt + r) * 72 + 16 * s + 8 * hh), qf[s], sc[kt]); }
    float mx = sink;
#pragma unroll
    for (int kt = 0; kt < 5; ++kt)
#pragma unroll
        for (int i = 0; i < 16; ++i) { const int j = j0 + 32 * kt + (i & 3) + 8 * (i >> 2) + 4 * hh; const bool ok = (j >= lo) && (j <= hi); const float s = ok ? sc[kt][i] * 0.125f : -1e30f; sc[kt][i] = s; mx = fmaxf(mx, s); }
    mx = fmaxf(mx, __shfl_xor(mx, 32));
    float sum = 0.f;
#pragma unroll
    for (int kt = 0; kt < 5; ++kt)
#pragma unroll
        for (int i = 0; i < 16; ++i) { const float e = __expf(sc[kt][i] - mx); sc[kt][i] = e; sum += e; }
    sum += __shfl_xor(sum, 32); sum += __expf(sink - mx); const float inv = 1.0f / sum;
    f32x16 o[2];
#pragma unroll
    for (int i = 0; i < 16; ++i) { o[0][i] = 0.f; o[1][i] = 0.f; }
#pragma unroll
    for (int kt = 0; kt < 5; ++kt)
#pragma unroll
        for (int s2 = 0; s2 < 2; ++s2) { u32x4 pw; pw.x = pk2(sc[kt][8 * s2 + 0] * inv, sc[kt][8 * s2 + 1] * inv); pw.y = pk2(sc[kt][8 * s2 + 2] * inv, sc[kt][8 * s2 + 3] * inv);
            pw.z = pk2(sc[kt][8 * s2 + 4] * inv, sc[kt][8 * s2 + 5] * inv); pw.w = pk2(sc[kt][8 * s2 + 6] * inv, sc[kt][8 * s2 + 7] * inv); const bf16x8 pb = __builtin_bit_cast(bf16x8, pw);
#pragma unroll
            for (int dt = 0; dt < 2; ++dt) { const bf16_t* vp = Vt + (32 * dt + r) * 264 + j0 + 32 * kt + 16 * s2 + 4 * hh; const s16x4 v0 = *(const s16x4*)vp, v1 = *(const s16x4*)(vp + 8);
                const bf16x8 vf = __builtin_shufflevector(v0, v1, 0, 1, 2, 3, 4, 5, 6, 7); o[dt] = MFMA32(vf, pb, o[dt]); } }
#pragma unroll
    for (int dt = 0; dt < 2; ++dt)
#pragma unroll
        for (int g4 = 0; g4 < 4; ++g4) *(uint2*)(optr + 32 * dt + 8 * g4 + 4 * hh) = make_uint2(pk2(o[dt][4 * g4], o[dt][4 * g4 + 1]), pk2(o[dt][4 * g4 + 2], o[dt][4 * g4 + 3]));
}
DI void attn_item(const Params& p, int item) {
    extern __shared__ __attribute__((aligned(16))) unsigned char shm[];
    unsigned char* ws = p.ws; const bf16_t* PROJ = (const bf16_t*)(ws + WS_PROJ); bf16_t* MIX = (bf16_t*)p.out;
    const int tid = opaque_tid(), wid = tid >> 6, lane = tid & 63, r = lane & 31;
    if (item < 256) {
        const int kvh = item & 1, blk = (item >> 1) & 63, b = item >> 7; bf16_t* Ks = (bf16_t*)shm; bf16_t* Vt = (bf16_t*)(shm + 256 * 72 * 2);
        for (int idx = tid; idx < 2048; idx += NTHREADS) { const int key = idx >> 3, d8 = (idx & 7) * 8; const int pos = blk * 128 - 128 + key; uint4 kv = make_uint4(0, 0, 0, 0), vv = make_uint4(0, 0, 0, 0);
            if (pos >= 0) { const bf16_t* src = PROJ + (size_t)(b * 8192 + pos) * 2560 + 512 + kvh * 64 + d8; kv = *(const uint4*)src; vv = *(const uint4*)(src + 128); }
            *(uint4*)(Ks + key * 72 + d8) = kv; bf16_t* vt = Vt + d8 * 264 + key;
            vt[0] = (bf16_t)(vv.x & 0xffff); vt[264] = (bf16_t)(vv.x >> 16); vt[2 * 264] = (bf16_t)(vv.y & 0xffff); vt[3 * 264] = (bf16_t)(vv.y >> 16);
            vt[4 * 264] = (bf16_t)(vv.z & 0xffff); vt[5 * 264] = (bf16_t)(vv.z >> 16); vt[6 * 264] = (bf16_t)(vv.w & 0xffff); vt[7 * 264] = (bf16_t)(vv.w >> 16); }
        __syncthreads();
#pragma unroll 1
        for (int it = 0; it < 2; ++it) { const int ti = wid * 2 + it, g = ti >> 2, qs = (ti & 3) * 32; const int head = kvh * 4 + g; const int m = b * 8192 + blk * 128 + qs + r;
            int lo = qs + r + 1; if (blk == 0 && lo < 128) lo = 128;
            attn_wave_tile(Ks, Vt, qs, PROJ + (size_t)m * 2560 + head * 64, lo, qs + r + 128, p.in[I_SINK][head], MIX + (size_t)m * 1024 + head * 64); }
        __syncthreads();
    } else {
        const int b = item - 256; bf16_t* Ks = (bf16_t*)shm; bf16_t* Vt = (bf16_t*)(shm + 320 * 72 * 2);
        for (int idx = tid; idx < 2 * 160 * 8; idx += NTHREADS) { const int kvh = idx / 1280, rem = idx % 1280, key = rem >> 3, d8 = (rem & 7) * 8; uint4 kv = make_uint4(0, 0, 0, 0), vv = make_uint4(0, 0, 0, 0);
            if (key < 128) { const size_t o = ((size_t)(b * 128 + key) * 2 + kvh) * 64 + d8; const float4 k0 = *(const float4*)(p.in[I_CK] + o), k1 = *(const float4*)(p.in[I_CK] + o + 4), v0 = *(const float4*)(p.in[I_CV] + o), v1 = *(const float4*)(p.in[I_CV] + o + 4);
                kv = make_uint4(pk2(k0.x, k0.y), pk2(k0.z, k0.w), pk2(k1.x, k1.y), pk2(k1.z, k1.w)); vv = make_uint4(pk2(v0.x, v0.y), pk2(v0.z, v0.w), pk2(v1.x, v1.y), pk2(v1.z, v1.w)); }
            else if (key < 136) { const bf16_t* src = PROJ + (size_t)(NP + b * 8 + key - 128) * 2560 + 512 + kvh * 64 + d8; kv = *(const uint4*)src; vv = *(const uint4*)(src + 128); }
            *(uint4*)(Ks + (kvh * 160 + key) * 72 + d8) = kv; bf16_t* vt = Vt + (kvh * 64 + d8) * 264 + key;
            vt[0] = (bf16_t)(vv.x & 0xffff); vt[264] = (bf16_t)(vv.x >> 16); vt[2 * 264] = (bf16_t)(vv.y & 0xffff); vt[3 * 264] = (bf16_t)(vv.y >> 16);
            vt[4 * 264] = (bf16_t)(vv.z & 0xffff); vt[5 * 264] = (bf16_t)(vv.z >> 16); vt[6 * 264] = (bf16_t)(vv.w & 0xffff); vt[7 * 264] = (bf16_t)(vv.w >> 16); }
        __syncthreads();
        if (wid < 2) { const int kvh = wid, g = r >> 3, t = r & 7, head = kvh * 4 + g, m = NP + b * 8 + t;
            attn_wave_tile(Ks + kvh * 160 * 72, Vt + kvh * 64 * 264, 0, PROJ + (size_t)m * 2560 + head * 64, t + 1, t + 128, p.in[I_SINK][head], MIX + (size_t)m * 1024 + head * 64); }
        __syncthreads();
    }
}

DI void phase_scan_sample(const Params& p) {
    extern __shared__ __attribute__((aligned(16))) unsigned char shm[];
    unsigned char* ws = p.ws; const int tid = opaque_tid(), wid = tid >> 6, lane = tid & 63;
    bf16_t* Rb = (bf16_t*)(ws + WS_R); const bf16_t* Kb = (const bf16_t*)(ws + WS_K); const bf16_t* Vb = (const bf16_t*)(ws + WS_V); const bf16_t* Ab = (const bf16_t*)(ws + WS_A); const bf16_t* Bb = (const bf16_t*)(ws + WS_B);
    const float* Wf = (const float*)(ws + WS_W); float* L = (float*)shm + wid * 2560;
    if (blockIdx.x < 64) return;
    for (int item = wid * (gridDim.x - 64) + (blockIdx.x - 64); item < 1024; item += 8 * (gridDim.x - 64)) {
        int m0, T, h; float* sout; float S[64];
        { const int s = item, b = s >> 3; h = s & 7; m0 = NP + b * 8; T = 8; sout = p.out + O_SS + ((size_t)(b * 8 + h) * 64 + lane) * 64; const float* sin = p.in[I_SW] + ((size_t)(b * 8 + h) * 64 + lane) * 64;
#pragma unroll
            for (int k4 = 0; k4 < 16; ++k4) { const float4 v = *(const float4*)(sin + 4 * k4); S[4 * k4] = v.x; S[4 * k4 + 1] = v.y; S[4 * k4 + 2] = v.z; S[4 * k4 + 3] = v.w; } }
#pragma unroll 1
        for (int t0 = 0; t0 < T; t0 += 8) {
            { const int st = lane >> 3, c8 = (lane & 7) * 8; const size_t o = (size_t)(m0 + t0 + st) * 512 + h * 64 + c8; float* l = L + st * 320 + c8;
                const uint4 ur = *(const uint4*)(Rb + o), uk = *(const uint4*)(Kb + o), ua = *(const uint4*)(Ab + o), ub = *(const uint4*)(Bb + o); const float4 w0 = *(const float4*)(Wf + o), w1 = *(const float4*)(Wf + o + 4);
                *(float4*)(l) = make_float4(bflo(ua.x), bfhi(ua.x), bflo(ua.y), bfhi(ua.y)); *(float4*)(l + 4) = make_float4(bflo(ua.z), bfhi(ua.z), bflo(ua.w), bfhi(ua.w));
                *(float4*)(l + 64) = make_float4(__expf(w0.x), __expf(w0.y), __expf(w0.z), __expf(w0.w)); *(float4*)(l + 68) = make_float4(__expf(w1.x), __expf(w1.y), __expf(w1.z), __expf(w1.w));
                *(float4*)(l + 128) = make_float4(bflo(ub.x), bfhi(ub.x), bflo(ub.y), bfhi(ub.y)); *(float4*)(l + 132) = make_float4(bflo(ub.z), bfhi(ub.z), bflo(ub.w), bfhi(ub.w));
                *(float4*)(l + 192) = make_float4(bflo(uk.x), bfhi(uk.x), bflo(uk.y), bfhi(uk.y)); *(float4*)(l + 196) = make_float4(bflo(uk.z), bfhi(uk.z), bflo(uk.w), bfhi(uk.w));
                *(float4*)(l + 256) = make_float4(bflo(ur.x), bfhi(ur.x), bflo(ur.y), bfhi(ur.y)); *(float4*)(l + 260) = make_float4(bflo(ur.z), bfhi(ur.z), bflo(ur.w), bfhi(ur.w)); }
            float vv[8];
#pragma unroll
            for (int j = 0; j < 8; ++j) vv[j] = bf1(Vb[(size_t)(m0 + t0 + j) * 512 + h * 64 + lane]);
            __builtin_amdgcn_fence(__ATOMIC_RELEASE, "wavefront"); __builtin_amdgcn_wave_barrier(); __builtin_amdgcn_fence(__ATOMIC_ACQUIRE, "wavefront");
#pragma unroll 1
            for (int j = 0; j < 8; ++j) { const float* l = L + j * 320; float sa = 0.f;
#pragma unroll
                for (int k4 = 0; k4 < 16; ++k4) { const float4 a = *(const float4*)(l + 4 * k4); sa += S[4 * k4] * a.x + S[4 * k4 + 1] * a.y + S[4 * k4 + 2] * a.z + S[4 * k4 + 3] * a.w; }
                float vj = vv[0];
#pragma unroll
                for (int q = 1; q < 8; ++q) vj = (j == q) ? vv[q] : vj;
                float o = 0.f;
#pragma unroll
                for (int k4 = 0; k4 < 16; ++k4) { const float4 w = *(const float4*)(l + 64 + 4 * k4), bq = *(const float4*)(l + 128 + 4 * k4), kq = *(const float4*)(l + 192 + 4 * k4), rq = *(const float4*)(l + 256 + 4 * k4);
                    S[4 * k4] = S[4 * k4] * w.x + sa * bq.x + vj * kq.x; S[4 * k4 + 1] = S[4 * k4 + 1] * w.y + sa * bq.y + vj * kq.y; S[4 * k4 + 2] = S[4 * k4 + 2] * w.z + sa * bq.z + vj * kq.z; S[4 * k4 + 3] = S[4 * k4 + 3] * w.w + sa * bq.w + vj * kq.w;
                    o += S[4 * k4] * rq.x + S[4 * k4 + 1] * rq.y + S[4 * k4 + 2] * rq.z + S[4 * k4 + 3] * rq.w; }
                Rb[(size_t)(m0 + t0 + j) * 512 + h * 64 + lane] = (bf16_t)(pk2(o, 0.f) & 0xffff); }
            __builtin_amdgcn_fence(__ATOMIC_RELEASE, "wavefront"); __builtin_amdgcn_wave_barrier(); __builtin_amdgcn_fence(__ATOMIC_ACQUIRE, "wavefront");
        }
#pragma unroll
        for (int k4 = 0; k4 < 16; ++k4) *(float4*)(sout + 4 * k4) = make_float4(S[4 * k4], S[4 * k4 + 1], S[4 * k4 + 2], S[4 * k4 + 3]);
    }
}

DI void phase_post(const Params& p) {
    unsigned char* ws = p.ws; const int tid = opaque_tid(), wid = tid >> 6, lane = tid & 63; bf16_t* MIX = (bf16_t*)p.out;
    const bf16_t* Ob = (const bf16_t*)(ws + WS_R); const bf16_t* Vb = (const bf16_t*)(ws + WS_V); const bf16_t* Gb = (const bf16_t*)(ws + WS_G); const float* BON = (const float*)(ws + WS_BONUS);
    const int h = lane >> 3, c8 = h * 64 + (lane & 7) * 8;
    float gg[8], gb[8];
#pragma unroll
    for (int j = 0; j < 8; ++j) { gg[j] = p.in[I_GNG][c8 + j]; gb[j] = p.in[I_GNB][c8 + j]; }
    for (int m = NP + blockIdx.x * 8 + wid; m < NTOK; m += gridDim.x * 8) { const size_t o = (size_t)m * 512 + c8;
        const uint4 uo = *(const uint4*)(Ob + o), uv = *(const uint4*)(Vb + o), ug = *(const uint4*)(Gb + o); const float bon = BON[(size_t)m * 8 + h];
        float x[8] = {bflo(uo.x), bfhi(uo.x), bflo(uo.y), bfhi(uo.y), bflo(uo.z), bfhi(uo.z), bflo(uo.w), bfhi(uo.w)};
        const float v[8] = {bflo(uv.x), bfhi(uv.x), bflo(uv.y), bfhi(uv.y), bflo(uv.z), bfhi(uv.z), bflo(uv.w), bfhi(uv.w)};
        const float g[8] = {bflo(ug.x), bfhi(ug.x), bflo(ug.y), bfhi(ug.y), bflo(ug.z), bfhi(ug.z), bflo(ug.w), bfhi(ug.w)};
        float s = 0.f;
#pragma unroll
        for (int j = 0; j < 8; ++j) s += x[j];
        s += __shfl_xor(s, 1); s += __shfl_xor(s, 2); s += __shfl_xor(s, 4); const float mean = s * (1.0f / 64.0f); float q = 0.f;
#pragma unroll
        for (int j = 0; j < 8; ++j) { x[j] -= mean; q += x[j] * x[j]; }
        q += __shfl_xor(q, 1); q += __shfl_xor(q, 2); q += __shfl_xor(q, 4); const float rs = rsqrtf(q * (1.0f / 64.0f) + 64e-5f);
        float y[8];
#pragma unroll
        for (int j = 0; j < 8; ++j) y[j] = (x[j] * rs * gg[j] + gb[j] + bon * v[j]) * g[j];
        *(uint4*)(MIX + (size_t)m * 1024 + 512 + c8) = make_uint4(pk2(y[0], y[1]), pk2(y[2], y[3]), pk2(y[4], y[5]), pk2(y[6], y[7])); }
}

DI void phase_final(const Params& p) {
    unsigned char* ws = p.ws; const int tid = opaque_tid(), wid = tid >> 6, lane = tid & 63; const float* X2 = (const float*)(ws + WS_X1); const float* PART = (const float*)(ws + WS_PART); const float* gf = p.in[I_GFIN];
    float4 g[4];
#pragma unroll
    for (int i = 0; i < 4; ++i) g[i] = *(const float4*)(gf + lane * 4 + 256 * i);
    for (int m = blockIdx.x * 8 + wid; m < NTOK; m += gridDim.x * 8) { float4 v[4]; float sq = 0.f;
#pragma unroll
        for (int i = 0; i < 4; ++i) { const uint2 xb = *(const uint2*)((const bf16_t*)(ws + WS_X1B) + (size_t)m * 1024 + lane * 4 + 256 * i); v[i] = make_float4(bflo(xb.x), bfhi(xb.x), bflo(xb.y), bfhi(xb.y)); }
        if (m >= NP) {
#pragma unroll
            for (int sl = 0; sl < 4; ++sl)
#pragma unroll
                for (int i = 0; i < 4; ++i) { const float4 q = *(const float4*)(PART + (size_t)sl * 1048576 + (size_t)(m - NP) * 1024 + lane * 4 + 256 * i); v[i].x += q.x; v[i].y += q.y; v[i].z += q.z; v[i].w += q.w; } }
#pragma unroll
        for (int i = 0; i < 4; ++i) sq += v[i].x * v[i].x + v[i].y * v[i].y + v[i].z * v[i].z + v[i].w * v[i].w;
#pragma unroll
        for (int o = 32; o >= 1; o >>= 1) sq += __shfl_xor(sq, o);
        const float rstd = rsqrtf(sq * (1.0f / 1024.0f) + 1e-6f);
#pragma unroll
        for (int i = 0; i < 4; ++i) { float4 y = v[i]; y.x *= rstd * g[i].x; y.y *= rstd * g[i].y; y.z *= rstd * g[i].z; y.w *= rstd * g[i].w;
            __builtin_nontemporal_store((f32x4){y.x, y.y, y.z, y.w}, (f32x4*)(p.out + O_Y + (size_t)m * 1024 + lane * 4 + 256 * i)); } }
}

constexpr int CS_AT = 0, CS_BT = 9216, CS_KT = 18432, CS_RT = 27648, CS_VT = 36864, CS_BHT = 46080, CS_KHT = 55296, CS_ADG = 64512, CS_AABB = 68608, CS_AAK = 81920, CS_ARB = 91136, CS_ARK = 100352, CS_RHS = 109568, CS_TOT = 142336, CS_GC = 144384;
DI bf16x8 ldsfrag(const bf16_t* base, int row, int s, int hh) { return *(const bf16x8*)(base + row * 72 + 16 * s + 8 * hh); }
struct ChunkRaw { float lw[8]; bf16_t a[8], b[8], k[8], r[8], v[8]; };
#define LBAR() do { asm volatile("s_waitcnt lgkmcnt(0)" ::: "memory"); __builtin_amdgcn_s_barrier(); asm volatile("" ::: "memory"); } while (0)
DI void chunk_load(const Params& p, int item, ChunkRaw& q) {
    unsigned char* ws = p.ws; const int tid_ = opaque_tid(), wid = tid_ >> 6, lane = tid_ & 63; const int sh = item >> 7, c = item & 127, b = sh >> 3, h = sh & 7, m0 = b * 8192 + c * 64;
    const size_t base = (size_t)(m0 + 8 * wid) * 512 + h * 64 + lane;
    const bf16_t* Rb = (const bf16_t*)(ws + WS_R); const bf16_t* Kb = (const bf16_t*)(ws + WS_K); const bf16_t* Vb = (const bf16_t*)(ws + WS_V); const bf16_t* Ab = (const bf16_t*)(ws + WS_A); const bf16_t* Bb = (const bf16_t*)(ws + WS_B); const float* Wf = (const float*)(ws + WS_W);
#pragma unroll
    for (int j = 0; j < 8; ++j) { q.lw[j] = Wf[base + j * 512]; q.a[j] = Ab[base + j * 512]; q.b[j] = Bb[base + j * 512]; q.k[j] = Kb[base + j * 512]; q.r[j] = Rb[base + j * 512]; q.v[j] = Vb[base + j * 512]; }
}
#ifdef PROBE_CH
#define CHT(i) do { const unsigned long long _t = wall_clock64(); cht[i] += _t - chl; chl = _t; } while (0)
DI void chunk_item(const Params& p, int item, int next_item, ChunkRaw& raw, unsigned long long* cht, unsigned long long& chl) {
#else
#define CHT(i) do {} while (0)
DI void chunk_item(const Params& p, int item, int next_item, ChunkRaw& raw) {
#endif
    extern __shared__ __attribute__((aligned(16))) unsigned char shm[];
    unsigned char* ws = p.ws; const int tid = opaque_tid(), wid = tid >> 6, lane = tid & 63, r = lane & 31, hh = lane >> 5;
    const int sh = item >> 7, c = item & 127, b = sh >> 3, h = sh & 7, m0 = b * 8192 + c * 64;
    bf16_t* AT = (bf16_t*)(shm + CS_AT); bf16_t* BT = (bf16_t*)(shm + CS_BT); bf16_t* KT = (bf16_t*)(shm + CS_KT); bf16_t* RT = (bf16_t*)(shm + CS_RT);
    bf16_t* VT = (bf16_t*)(shm + CS_VT); bf16_t* BHT = (bf16_t*)(shm + CS_BHT); bf16_t* KHT = (bf16_t*)(shm + CS_KHT); float* ADG = (float*)(shm + CS_ADG); bf16_t* AABb = (bf16_t*)(shm + CS_AABB);
    bf16_t* AAK = (bf16_t*)(shm + CS_AAK); bf16_t* ARB = (bf16_t*)(shm + CS_ARB); bf16_t* ARK = (bf16_t*)(shm + CS_ARK); float* RHS = (float*)(shm + CS_RHS);
    float* TOT = (float*)(shm + CS_TOT); float* GC = (float*)(shm + CS_GC); bf16_t* W1T = AT; bf16_t* W2T = BT;
    const bf16_t* Rb = (const bf16_t*)(ws + WS_R); const bf16_t* Kb = (const bf16_t*)(ws + WS_K); const bf16_t* Vb = (const bf16_t*)(ws + WS_V); const bf16_t* Ab = (const bf16_t*)(ws + WS_A); const bf16_t* Bb = (const bf16_t*)(ws + WS_B);
    float* Wf = (float*)(ws + WS_W);
#ifndef NO_S1
    {
        const int k = lane;
        float lw[8], cs[8], av[8], bv[8], kv[8], rv[8], vv[8];
#pragma unroll
        for (int j = 0; j < 8; ++j) { lw[j] = raw.lw[j]; av[j] = bf1(raw.a[j]); bv[j] = bf1(raw.b[j]); kv[j] = bf1(raw.k[j]); rv[j] = bf1(raw.r[j]); vv[j] = bf1(raw.v[j]); }
        cs[0] = lw[0];
#pragma unroll
        for (int j = 1; j < 8; ++j) cs[j] = cs[j - 1] + lw[j];
        TOT[wid * 64 + k] = cs[7];
        LBAR();
        float off = 0.f, tot = 0.f;
#pragma unroll
        for (int ww = 0; ww < 8; ++ww) { const float x = TOT[ww * 64 + k]; off += (ww < wid) ? x : 0.f; tot += x; }
        float bh8[8], kh8[8];
        const float etot = __expf(tot); float gprev = __expf(off + cs[0] - lw[0]);
#pragma unroll
        for (int j = 0; j < 8; ++j) { const int t = 8 * wid + j; const float cc = off + cs[j]; const float g = __expf(cc), gi = __builtin_amdgcn_rcpf(g), gp = gprev, gh = etot * gi; gprev = g;
            const float at = av[j] * gp; AT[t * 72 + k] = (bf16_t)(pk2(at, 0.f) & 0xffff); BT[t * 72 + k] = (bf16_t)(pk2(bv[j] * gi, 0.f) & 0xffff); KT[t * 72 + k] = (bf16_t)(pk2(kv[j] * gi, 0.f) & 0xffff);
            RT[t * 72 + k] = (bf16_t)(pk2(rv[j] * g, 0.f) & 0xffff); RHS[t * 128 + k] = at; bh8[j] = bv[j] * gh; kh8[j] = kv[j] * gh; }
        *(uint4*)(VT + k * 72 + 8 * wid) = make_uint4(pk2(vv[0], vv[1]), pk2(vv[2], vv[3]), pk2(vv[4], vv[5]), pk2(vv[6], vv[7]));
        *(uint4*)(BHT + k * 72 + 8 * wid) = make_uint4(pk2(bh8[0], bh8[1]), pk2(bh8[2], bh8[3]), pk2(bh8[4], bh8[5]), pk2(bh8[6], bh8[7]));
        *(uint4*)(KHT + k * 72 + 8 * wid) = make_uint4(pk2(kh8[0], kh8[1]), pk2(kh8[2], kh8[3]), pk2(kh8[4], kh8[5]), pk2(kh8[6], kh8[7]));
        if (wid == 0) GC[k] = __expf(tot);
    }
    if (next_item < 2048) chunk_load(p, next_item, raw);
#endif
    LBAR();
    CHT(0);
#ifndef NO_S2
#pragma unroll
    for (int i2 = 0; i2 < 2; ++i2) { const int job = wid * 2 + i2, mi = job >> 2, tt = (job >> 1) & 1, jt = job & 1;
        f32x16 D;
#pragma unroll
        for (int i = 0; i < 16; ++i) D[i] = 0.f;
        if (!(tt == 0 && jt == 1)) { const bf16_t* Lop = (mi < 2) ? AT : RT; const bf16_t* Rop = (mi & 1) ? KT : BT;
#pragma unroll
            for (int s = 0; s < 4; ++s) D = MFMA32(ldsfrag(Rop, 32 * jt + r, s, hh), ldsfrag(Lop, 32 * tt + r, s, hh), D); }
        const int t = 32 * tt + r;
#pragma unroll
        for (int g4 = 0; g4 < 4; ++g4) { const int j0 = 32 * jt + 8 * g4 + 4 * hh; float v[4];
#pragma unroll
            for (int e = 0; e < 4; ++e) { const int j = j0 + e; const bool ok = (mi < 2) ? (j < t) : (j <= t); v[e] = ok ? D[4 * g4 + e] : 0.f; }
            if (mi == 0 && (t >> 4) == (j0 >> 4)) *(float4*)(ADG + (t >> 4) * 256 + (t & 15) * 16 + (j0 & 15)) = make_float4(v[0], v[1], v[2], v[3]);
            { bf16_t* dst = (mi == 0 ? AABb : (mi == 1 ? AAK : (mi == 2 ? ARB : ARK))) + t * 72 + j0; *(uint2*)dst = make_uint2(pk2(v[0], v[1]), pk2(v[2], v[3])); } } }
#endif
    LBAR();
    CHT(1);
    bf16_t* TINV = (bf16_t*)(shm + CS_TOT);
    if (wid == 4) { const int Ib = lane >> 4, cc = lane & 15; const float* dg = ADG + Ib * 256; float t[16];
#pragma unroll
        for (int rr = 0; rr < 16; ++rr) t[rr] = (rr == cc) ? 1.f : 0.f;
#pragma unroll
        for (int rr = 1; rr < 16; ++rr) { float part[4] = {0.f, 0.f, 0.f, 0.f};
#pragma unroll
            for (int g = 0; g < (rr + 3) / 4; ++g) { const float4 av = *(const float4*)(dg + rr * 16 + 4 * g); part[g] = av.x * t[4 * g] + av.y * t[4 * g + 1] + av.z * t[4 * g + 2] + av.w * t[4 * g + 3]; }
            t[rr] += (part[0] + part[1]) + (part[2] + part[3]); }
#pragma unroll
        for (int rr = 0; rr < 16; ++rr) TINV[(Ib * 16 + rr) * 16 + cc] = (bf16_t)(pk2a(t[rr], 0.f) & 0xffffu); }
    if (wid < 4) { const int tt = wid >> 1, vt = wid & 1; f32x16 D;
#pragma unroll
        for (int i = 0; i < 16; ++i) D[i] = 0.f;
#pragma unroll
        for (int s = 0; s < 4; ++s) D = MFMA32(ldsfrag(AAK, 32 * tt + r, s, hh), ldsfrag(VT, 32 * vt + r, s, hh), D);
#pragma unroll
        for (int i = 0; i < 16; ++i) RHS[(32 * tt + (i & 3) + 8 * (i >> 2) + 4 * hh) * 128 + 64 + 32 * vt + r] = D[i]; }
    LBAR();
    CHT(2);
#ifndef NO_S4
    { const int cl = lane & 15, q4 = lane >> 4, col = 16 * wid + cl, s0 = cl + 32 * (q4 & 1), s1 = s0 + 16;
        f32x4 R[4];
#pragma unroll
        for (int T = 0; T < 4; ++T)
#pragma unroll
            for (int e = 0; e < 4; ++e) R[T][e] = RHS[(16 * T + 4 * q4 + e) * 128 + col];
        bf16_t* wt = (col < 64) ? (W1T + col * 72) : (W2T + (col - 64) * 72);
#define CS_BFRAG(V, out) { const float b0 = __shfl(V[0], s0), b1 = __shfl(V[1], s0), b2 = __shfl(V[2], s0), b3 = __shfl(V[3], s0), b4 = __shfl(V[0], s1), b5 = __shfl(V[1], s1), b6 = __shfl(V[2], s1), b7 = __shfl(V[3], s1); \
            u32x4 bw_; bw_.x = pk2(b0, b1); bw_.y = pk2(b2, b3); bw_.z = pk2(b4, b5); bw_.w = pk2(b6, b7); if (q4 >= 2) bw_ = (u32x4){0u, 0u, 0u, 0u}; out = __builtin_bit_cast(bf16x8, bw_); }
#pragma unroll
        for (int I = 0; I < 4; ++I) { bf16x8 rb; CS_BFRAG(R[I], rb)
            u32x4 tw = *(const u32x4*)(TINV + (I * 16 + cl) * 16 + 8 * (q4 & 1)); if (q4 >= 2) tw = (u32x4){0u, 0u, 0u, 0u};
            const f32x4 X = MFMA16(__builtin_bit_cast(bf16x8, tw), rb, ((f32x4){0.f, 0.f, 0.f, 0.f}));
            *(uint2*)(wt + 16 * I + 4 * q4) = make_uint2(pk2(X[0], X[1]), pk2(X[2], X[3]));
            if (I < 3) { bf16x8 xb; CS_BFRAG(X, xb)
#pragma unroll
                for (int T = I + 1; T < 4; ++T) { u32x4 aw = *(const u32x4*)(AABb + (16 * T + cl) * 72 + 16 * I + 8 * (q4 & 1)); if (q4 >= 2) aw = (u32x4){0u, 0u, 0u, 0u};
                    R[T] = MFMA16(__builtin_bit_cast(bf16x8, aw), xb, R[T]); } }
        }
#undef CS_BFRAG
    }
#endif
    LBAR();
    CHT(3);
#ifndef NO_S5
    bf16_t* MTg = (bf16_t*)(ws + WS_MT) + (size_t)item * 4096; float* Ng = (float*)(ws + WS_N) + (size_t)item * 4096; bf16_t* QTg = (bf16_t*)(ws + WS_QT) + (size_t)item * 4096;
#pragma unroll
    for (int i2 = 0; i2 < 2; ++i2) { const int job = wid * 2 + i2, kind = job >> 2, ta = (job >> 1) & 1, tb = job & 1;
        const bf16_t* A1 = (kind == 0 || kind == 2) ? W1T : (kind == 1 ? W2T : BHT); const bf16_t* B1 = (kind < 2) ? ARB : (kind == 2 ? BHT : W2T);
        f32x16 D;
#pragma unroll
        for (int i = 0; i < 16; ++i) D[i] = 0.f;
#pragma unroll
        for (int s = 0; s < 4; ++s) D = MFMA32(ldsfrag(A1, 32 * tb + r, s, hh), ldsfrag(B1, 32 * ta + r, s, hh), D);
        if (kind & 1) { const bf16_t* A2 = (kind == 1) ? VT : KHT; const bf16_t* B2 = (kind == 1) ? ARK : VT;
#pragma unroll
            for (int s = 0; s < 4; ++s) D = MFMA32(ldsfrag(A2, 32 * tb + r, s, hh), ldsfrag(B2, 32 * ta + r, s, hh), D); }
        const int col = 32 * ta + r;
#pragma unroll
        for (int g4 = 0; g4 < 4; ++g4) { const int r0 = 32 * tb + 8 * g4 + 4 * hh;
            float v[4] = {D[4 * g4], D[4 * g4 + 1], D[4 * g4 + 2], D[4 * g4 + 3]};
            if (kind == 0) { float q[4]; load4bf(RT + col * 72 + r0, q); *(uint2*)(QTg + col * 64 + r0) = make_uint2(pk2(v[0] + q[0], v[1] + q[1]), pk2(v[2] + q[2], v[3] + q[3])); }
            else if (kind == 1) { *(uint2*)((bf16_t*)(ws + WS_R) + (size_t)(m0 + col) * 512 + h * 64 + r0) = make_uint2(pk2(v[0], v[1]), pk2(v[2], v[3])); }
            else if (kind == 2) {
#pragma unroll
                for (int e = 0; e < 4; ++e) if (r0 + e == col) v[e] += GC[col];
                *(uint2*)(MTg + col * 64 + r0) = make_uint2(pk2(v[0], v[1]), pk2(v[2], v[3])); }
            else { *(float4*)(Ng + col * 64 + r0) = make_float4(v[0], v[1], v[2], v[3]); } } }
#endif
    LBAR();
    CHT(4);
}

constexpr int PR_NCH = 64, PR_SLOT = 13568, PR_NSLOT = 8, PR_FLAGS = PR_SLOT * PR_NSLOT;
DI void phase_prop(const Params& p) {
    extern __shared__ __attribute__((aligned(16))) unsigned char shm[];
    unsigned char* ws = p.ws; const int tid = opaque_tid(), wid = tid >> 6, lane = tid & 63, vl = lane & 15, q = lane >> 4;
    if (blockIdx.x >= PR_NCH) { phase_scan_sample(p); return; }
    int* flags = (int*)(shm + PR_FLAGS);
    if (tid < 16) flags[tid] = 0;
    __syncthreads();
    const int sh = blockIdx.x >> 2, vq = blockIdx.x & 3, vrow = 16 * vq + vl;
    if (wid > 0) {
        const uint4* MtB = (const uint4*)((const bf16_t*)(ws + WS_MT) + (size_t)sh * 128 * 4096) + lane; const uint4* NgB = (const uint4*)((const float*)(ws + WS_N) + (size_t)sh * 128 * 4096 + vq * 1024) + lane;
#define PR_LD(S, k) S##m##k = MtB[(size_t)cc * 512 + 64 * k];
#define PR_LDN(S, k) S##n##k = NgB[(size_t)cc * 1024 + 64 * k];
#define PR_LOAD(S, step) { const int cc = (step); PR_LD(S, 0) PR_LD(S, 1) PR_LD(S, 2) PR_LD(S, 3) PR_LD(S, 4) PR_LD(S, 5) PR_LD(S, 6) PR_LD(S, 7) PR_LDN(S, 0) PR_LDN(S, 1) PR_LDN(S, 2) PR_LDN(S, 3) }
#define PR_ST(S, k) { const int im = lane + 64 * k; *(uint4*)(slot + (im >> 3) * 144 + (im & 7) * 16) = S##m##k; }
#define PR_STN(S, k) { const int im = lane + 64 * k; *(uint4*)(slot + 9216 + (im >> 4) * 272 + (im & 15) * 16) = S##n##k; }
#define PR_STORE(S, step) { const int cc = (step); while (__hip_atomic_load(flags + 8, __ATOMIC_ACQUIRE, __HIP_MEMORY_SCOPE_WORKGROUP) < cc - 7) __builtin_amdgcn_s_sleep(1); \
            unsigned char* slot = shm + (cc & 7) * PR_SLOT; PR_ST(S, 0) PR_ST(S, 1) PR_ST(S, 2) PR_ST(S, 3) PR_ST(S, 4) PR_ST(S, 5) PR_ST(S, 6) PR_ST(S, 7) PR_STN(S, 0) PR_STN(S, 1) PR_STN(S, 2) PR_STN(S, 3) \
            __hip_atomic_store(flags + (cc & 7), cc + 1, __ATOMIC_RELEASE, __HIP_MEMORY_SCOPE_WORKGROUP); }
        uint4 Am0, Am1, Am2, Am3, Am4, Am5, Am6, Am7, An0, An1, An2, An3, Bm0, Bm1, Bm2, Bm3, Bm4, Bm5, Bm6, Bm7, Bn0, Bn1, Bn2, Bn3;
        int c = wid - 1;
        PR_LOAD(A, c)
#pragma unroll 1
        for (; c < 128; c += 14) {
            if (c + 7 < 128) PR_LOAD(B, c + 7)
            PR_STORE(A, c)
            if (c + 14 < 128) PR_LOAD(A, c + 14)
            if (c + 7 < 128) PR_STORE(B, c + 7)
        }
#undef PR_LD
#undef PR_LDN
#undef PR_LOAD
#undef PR_ST
#undef PR_STN
#undef PR_STORE
        return;
    }
    f32x4 acc[4]; bf16x8 Sb[2];
#pragma unroll
    for (int nt = 0; nt < 4; ++nt) acc[nt] = (f32x4){0.f, 0.f, 0.f, 0.f};
    Sb[0] = (bf16x8){0, 0, 0, 0, 0, 0, 0, 0}; Sb[1] = Sb[0];
#pragma unroll 1
    for (int c = 0; c < 128; ++c) { const size_t item = (size_t)sh * 128 + c; bf16_t* SC = (bf16_t*)(ws + WS_SC) + item * 4096; const unsigned char* slot = shm + (c & 7) * PR_SLOT;
#pragma unroll
        for (int s = 0; s < 2; ++s) { const u32x4 u = __builtin_bit_cast(u32x4, Sb[s]); *(uint2*)(SC + vrow * 64 + 32 * s + 4 * q) = make_uint2(u.x, u.y); *(uint2*)(SC + vrow * 64 + 32 * s + 16 + 4 * q) = make_uint2(u.z, u.w); }
        while (__hip_atomic_load(flags + (c & 7), __ATOMIC_ACQUIRE, __HIP_MEMORY_SCOPE_WORKGROUP) != c + 1) __builtin_amdgcn_s_sleep(1);
#pragma unroll
        for (int nt = 0; nt < 4; ++nt) acc[nt] = *(const f32x4*)(slot + 9216 + vl * 272 + (16 * nt + 4 * q) * 4);
        bf16x8 mf[2][4];
#pragma unroll
        for (int s = 0; s < 2; ++s)
#pragma unroll
            for (int nt = 0; nt < 4; ++nt) { const unsigned char* mp = slot + (16 * nt + vl) * 144 + (32 * s + 4 * q) * 2; const s16x4 a0 = *(const s16x4*)mp, a1 = *(const s16x4*)(mp + 32); mf[s][nt] = __builtin_shufflevector(a0, a1, 0, 1, 2, 3, 4, 5, 6, 7); }
        asm volatile("s_waitcnt lgkmcnt(0)" ::: "memory");
        __builtin_amdgcn_sched_barrier(0);
        __hip_atomic_store(flags + 8, c + 1, __ATOMIC_RELAXED, __HIP_MEMORY_SCOPE_WORKGROUP);
#pragma unroll
        for (int s = 0; s < 2; ++s)
#pragma unroll
            for (int nt = 0; nt < 4; ++nt) acc[nt] = MFMA16(mf[s][nt], Sb[s], acc[nt]);
#pragma unroll
        for (int s = 0; s < 2; ++s) { u32x4 u; u.x = pk2(acc[2 * s][0], acc[2 * s][1]); u.y = pk2(acc[2 * s][2], acc[2 * s][3]); u.z = pk2(acc[2 * s + 1][0], acc[2 * s + 1][1]); u.w = pk2(acc[2 * s + 1][2], acc[2 * s + 1][3]);
            Sb[s] = __builtin_bit_cast(bf16x8, u); }
    }
    float* so = p.out + O_SP + ((size_t)sh * 64 + vrow) * 64;
#pragma unroll
    for (int nt = 0; nt < 4; ++nt) *(f32x4*)(so + 16 * nt + 4 * q) = acc[nt];
}

DI void phase_out(const Params& p) {
    unsigned char* ws = p.ws; const int tid = opaque_tid(), wid = tid >> 6, lane = tid & 63, r = lane & 31, hh = lane >> 5; bf16_t* MIX = (bf16_t*)p.out;
    const bf16_t* Vb = (const bf16_t*)(ws + WS_V); const bf16_t* Gb = (const bf16_t*)(ws + WS_G); const float* BON = (const float*)(ws + WS_BONUS); const bf16_t* OLb = (const bf16_t*)(ws + WS_R);
    for (int chunk = blockIdx.x; chunk < 256; chunk += gridDim.x) { const int b = chunk >> 7, c = chunk & 127, h = wid; const size_t item = (size_t)(b * 8 + h) * 128 + c; const int m0 = chunk * 64;
        const bf16_t* QTg = (const bf16_t*)(ws + WS_QT) + item * 4096; const bf16_t* SC = (const bf16_t*)(ws + WS_SC) + item * 4096;
#pragma unroll 1
        for (int tt = 0; tt < 2; ++tt) { f32x16 D[2];
#pragma unroll
            for (int i = 0; i < 16; ++i) { D[0][i] = 0.f; D[1][i] = 0.f; }
            bf16x8 bq[4], sf[4][2];
#pragma unroll
            for (int s = 0; s < 4; ++s) { bq[s] = *(const bf16x8*)(QTg + (32 * tt + r) * 64 + 16 * s + 8 * hh);
#pragma unroll
                for (int vt = 0; vt < 2; ++vt) sf[s][vt] = *(const bf16x8*)(SC + (32 * vt + r) * 64 + 16 * s + 8 * hh); }
#pragma unroll
            for (int s = 0; s < 4; ++s)
#pragma unroll
                for (int vt = 0; vt < 2; ++vt) D[vt] = MFMA32(sf[s][vt], bq[s], D[vt]);
            const int m = m0 + 32 * tt + r; const size_t ob = (size_t)m * 512 + h * 64 + 4 * hh; float sum = 0.f;
#pragma unroll
            for (int vt = 0; vt < 2; ++vt)
#pragma unroll
                for (int g4 = 0; g4 < 4; ++g4) { float ol[4]; load4bf(OLb + ob + 32 * vt + 8 * g4, ol); D[vt][4 * g4] += ol[0]; D[vt][4 * g4 + 1] += ol[1]; D[vt][4 * g4 + 2] += ol[2]; D[vt][4 * g4 + 3] += ol[3];
                    sum += D[vt][4 * g4] + D[vt][4 * g4 + 1] + D[vt][4 * g4 + 2] + D[vt][4 * g4 + 3]; }
            sum += __shfl_xor(sum, 32); const float mean = sum * (1.0f / 64.0f); float q = 0.f;
#pragma unroll
            for (int vt = 0; vt < 2; ++vt)
#pragma unroll
                for (int i = 0; i < 16; ++i) { D[vt][i] -= mean; q += D[vt][i] * D[vt][i]; }
            q += __shfl_xor(q, 32); const float rs = rsqrtf(q * (1.0f / 64.0f) + 64e-5f); const float bon = BON[(size_t)m * 8 + h];
#pragma unroll
            for (int vt = 0; vt < 2; ++vt)
#pragma unroll
                for (int g4 = 0; g4 < 4; ++g4) { const int c0 = 32 * vt + 8 * g4; const float4 gg = *(const float4*)(p.in[I_GNG] + h * 64 + 4 * hh + c0), gb = *(const float4*)(p.in[I_GNB] + h * 64 + 4 * hh + c0);
                    float v4[4], g4v[4]; load4bf(Vb + ob + c0, v4); load4bf(Gb + ob + c0, g4v);
                    const float y0 = (D[vt][4 * g4] * rs * gg.x + gb.x + bon * v4[0]) * g4v[0], y1 = (D[vt][4 * g4 + 1] * rs * gg.y + gb.y + bon * v4[1]) * g4v[1];
                    const float y2 = (D[vt][4 * g4 + 2] * rs * gg.z + gb.z + bon * v4[2]) * g4v[2], y3 = (D[vt][4 * g4 + 3] * rs * gg.w + gb.w + bon * v4[3]) * g4v[3];
                    *(uint2*)(MIX + (size_t)m * 1024 + 512 + h * 64 + 4 * hh + c0) = make_uint2(pk2(y0, y1), pk2(y2, y3)); }
        }
    }
    phase_post(p);
}

#define XB_TMO      128
#define XB_XCNT(j)  (256  + 64 * (j))
#define XB_XSUB(j)  (1280 + 64 * (j))
#define XB_XGEN(j)  (2304 + 64 * (j))
#define XB_TOP      3328
#define XB_TOPGEN   3392
#define XCD_BAR_WORDS 3456
#define XB_SPIN_CAP (1u << 18)
#define LAS __attribute__((address_space(3)))

__device__ __forceinline__ unsigned xb_ld(unsigned* p)              { return __hip_atomic_load(p, __ATOMIC_RELAXED, __HIP_MEMORY_SCOPE_AGENT); }
__device__ __forceinline__ unsigned xb_add(unsigned* p, unsigned v) { return __hip_atomic_fetch_add(p, v, __ATOMIC_RELAXED, __HIP_MEMORY_SCOPE_AGENT); }
__device__ __forceinline__ unsigned xb_xcc_id() { return (unsigned)__builtin_amdgcn_s_getreg((3 << 11) | 20) & 0xFu; }
#define XB_SPIN(cond, bar) do { unsigned _sp = 0; while (cond) { __builtin_amdgcn_s_sleep(1); \
    if ((++_sp & 255u) == 0u) { if (xb_ld(&(bar)[XB_TMO])) break; if (_sp > XB_SPIN_CAP) { atomicAdd(&(bar)[XB_TMO], 1u); break; } } } } while (0)

struct XcdBarrier {
    unsigned* bar; unsigned x;
    volatile LAS unsigned* st;
};

__device__ __forceinline__ XcdBarrier xcd_barrier_post(unsigned* bar, volatile LAS unsigned* st) {
    XcdBarrier b; b.bar = bar; b.x = xb_xcc_id(); b.st = st;
    if (threadIdx.x == 0) (void)xb_add(&bar[XB_XCNT(b.x)], 1u);
    return b;
}
__device__ __forceinline__ void xcd_barrier_complete(unsigned* bar, unsigned x, unsigned& nloc, unsigned& nx) {
    const unsigned G = gridDim.x * gridDim.y * gridDim.z;
    unsigned sum, cnt, mine, sp = 0u;
    for (;;) {
        sum = 0u; cnt = 0u; mine = 0u;
#pragma unroll
        for (unsigned j = 0; j < 16; ++j) { const unsigned c = xb_ld(&bar[XB_XCNT(j)]); sum += c; cnt += (c > 0u) ? 1u : 0u; mine = (j == x) ? c : mine; }
        if (sum == G) break;
        __builtin_amdgcn_s_sleep(1);
        if ((++sp & 255u) == 0u) { if (xb_ld(&bar[XB_TMO])) break; if (sp > XB_SPIN_CAP) { atomicAdd(&bar[XB_TMO], 1u); break; } }
    }
    nloc = mine > 0u ? mine : 1u; nx = cnt > 0u ? cnt : 1u;
}

__device__ __forceinline__ void xcd_barrier(const XcdBarrier& b) {
    asm volatile("s_waitcnt vmcnt(0)" ::: "memory");
    __syncthreads();
    if (threadIdx.x == 0) {
        unsigned* bar = b.bar;
        __builtin_amdgcn_s_waitcnt(0);
        unsigned nloc = b.st[0], nx = b.st[1];
        if (nloc == 0u) { xcd_barrier_complete(bar, b.x, nloc, nx); b.st[0] = nloc; b.st[1] = nx; }
        const unsigned old = xb_add(&bar[XB_XSUB(b.x)], 1u);
        const unsigned gen = old / nloc;
        if (old + 1u == (gen + 1u) * nloc) {
            __builtin_amdgcn_fence(__ATOMIC_RELEASE, "agent");
            asm volatile("s_waitcnt vmcnt(0)" ::: "memory");
            const unsigned og = xb_add(&bar[XB_TOP], 1u);
            const unsigned tg = og / nx;
            if (og + 1u == (tg + 1u) * nx) xb_add(&bar[XB_TOPGEN], 1u);
            else XB_SPIN(xb_ld(&bar[XB_TOPGEN]) == tg, bar);
            __builtin_amdgcn_fence(__ATOMIC_ACQUIRE, "agent");
            xb_add(&bar[XB_XGEN(b.x)], 1u);
            asm volatile("s_waitcnt vmcnt(0)" ::: "memory");
        } else {
            XB_SPIN(xb_ld(&bar[XB_XGEN(b.x)]) == gen, bar);
            __builtin_amdgcn_fence(__ATOMIC_ACQUIRE, "agent");
            asm volatile("s_waitcnt vmcnt(0)" ::: "memory");
        }
    }
    __syncthreads();
}


__global__ void __launch_bounds__(NTHREADS, 2) hymba_fwd(Params p) {
    extern __shared__ __attribute__((aligned(16))) unsigned char shm[];
    cg::grid_group grid = cg::this_grid();
    unsigned char* ws = p.ws; const int G = (int)gridDim.x;
    volatile LAS unsigned* xst = (volatile LAS unsigned*)((PG8_LAS unsigned char*)shm + (LDS_BYTES - 16));
    if (threadIdx.x == 0) { xst[0] = 0u; xst[1] = 0u; }
    __syncthreads();
    const XcdBarrier xb = xcd_barrier_post((unsigned*)(ws + WS_BAR), xst);
#ifdef PROBE_A
    unsigned long long tsv[20]; int tsn = 0;
#define TSTAMP() do { tsv[tsn++] = wall_clock64(); } while (0)
#else
#define TSTAMP() do {} while (0)
#endif
    TSTAMP();
#ifdef EXP_EMPTYPHASE
    grid.sync(); TSTAMP();
    grid.sync(); TSTAMP();
#endif
    phase_prep(p);
    if (p.ws == nullptr) grid.sync();
    xcd_barrier(xb); TSTAMP();
    { pg8::Gemm g{(const bf16_t*)p.out, (const bf16_t*)(ws + WS_WIN), M1, 2560, 1024, 1024, 1024}; pg8::StaticOrder S; S.init(g.M, g.N, G, (int)blockIdx.x);
      pg8::EpiProj E{(bf16_t*)(ws + WS_PROJ), p.out + O_KWP, p.out + O_VWP, p.out + O_KWS, p.out + O_VWS};
      pg8::gemm_phase<pg8::EpiProj, pg8::StaticOrder, false>((PG8_LAS unsigned char*)shm, g, S, E, nullptr); }
    xcd_barrier(xb); TSTAMP();
    {
        unsigned* qctr = (unsigned*)(ws + WS_BAR); volatile LAS int* qslot = (volatile LAS int*)((PG8_LAS unsigned char*)shm + (LDS_BYTES - 32));
#pragma unroll 1
        for (;;) { if (threadIdx.x == 0) *qslot = (int)atomicAdd(qctr, 1u); __syncthreads(); const int q = __builtin_amdgcn_readfirstlane(*qslot); __syncthreads(); if (q >= 928) break;
            if (q < 544) rwkv_prep_unit(p, q); else attn_item(p, q - 544); }
    }
    xcd_barrier(xb); TSTAMP();
    { ChunkRaw raw; if ((int)blockIdx.x < 2048) chunk_load(p, blockIdx.x, raw);
#ifdef PROBE_CH
      unsigned long long cht[5] = {0, 0, 0, 0, 0}; unsigned long long chl = wall_clock64();
      for (int it = blockIdx.x; it < 2048; it += G) chunk_item(p, it, it + G, raw, cht, chl);
      tsv[16] = 0; tsv[17] = cht[PROBE_CH]; tsv[18] = 0; tsv[19] = cht[PROBE_CH2];
#else
      for (int it = blockIdx.x; it < 2048; it += G) chunk_item(p, it, it + G, raw);
#endif
    }
    xcd_barrier(xb); TSTAMP();
    phase_prop(p);
    xcd_barrier(xb); TSTAMP();
    phase_out(p);
    xcd_barrier(xb); TSTAMP();
    const int cB = (int)blockIdx.x;
    {
        pg8::Gemm g{(const bf16_t*)p.out, (const bf16_t*)(ws + WS_WOUT), NP, 1024, 1024, 1024, 1024}; pg8::StaticOrder S; S.init(g.M, g.N, G, cB);
        pg8::EpiRes<true> E{p.in[I_XP], p.in[I_XS], (float*)(ws + WS_X1), (bf16_t*)(ws + WS_X1B), (float*)(ws + WS_SS1), 0};
        pg8::gemm_phase<pg8::EpiRes<true>, pg8::StaticOrder, false>((PG8_LAS unsigned char*)shm, g, S, E, nullptr); }
    {
        pg8::Gemm g{(const bf16_t*)p.out + (size_t)NP * 1024, (const bf16_t*)(ws + WS_WOUT), 1024, 1024, 1024, 1024, 1024}; pg8::StaticOrder S; S.init(g.M, g.N, G, cB);
        pg8::EpiRes<true> E{p.in[I_XP], p.in[I_XS], (float*)(ws + WS_X1), (bf16_t*)(ws + WS_X1B), (float*)(ws + WS_SS1), NP};
        pg8::gemm_phase<pg8::EpiRes<true>, pg8::StaticOrder, false>((PG8_LAS unsigned char*)shm, g, S, E, nullptr); }
    xcd_barrier(xb); TSTAMP();
    {
        pg8::Gemm g{(const bf16_t*)(ws + WS_X1B), (const bf16_t*)(ws + WS_WGU), NP, 5632, 1024, 1024, 1024}; pg8::StaticOrder S; S.init(g.M, g.N, G, cB);
        pg8::EpiAct E{(bf16_t*)(ws + WS_ACT), (const float*)(ws + WS_SS1), 0};
        pg8::gemm_phase<pg8::EpiAct, pg8::StaticOrder, false>((PG8_LAS unsigned char*)shm, g, S, E, nullptr); }
    {
        pg8::Gemm g{(const bf16_t*)(ws + WS_X1B) + (size_t)NP * 1024, (const bf16_t*)(ws + WS_WGU), 1024, 5632, 1024, 1024, 1024}; pg8::StaticOrder S; S.init(g.M, g.N, G, (cB + G / 2) % G);
        pg8::EpiAct E{(bf16_t*)(ws + WS_ACT), (const float*)(ws + WS_SS1), NP};
        pg8::gemm_phase<pg8::EpiAct, pg8::StaticOrder, false>((PG8_LAS unsigned char*)shm, g, S, E, nullptr); }
    xcd_barrier(xb); TSTAMP();
    {
        pg8::Gemm g{(const bf16_t*)(ws + WS_ACT), (const bf16_t*)(ws + WS_WD), NP, 1024, 2816, 2816, 2816}; pg8::StaticOrder S; S.init(g.M, g.N, G, cB);
        pg8::EpiRes<false> E{nullptr, nullptr, (float*)(ws + WS_X1), (bf16_t*)(ws + WS_X1B), nullptr, 0};
        pg8::gemm_phase<pg8::EpiRes<false>, pg8::StaticOrder, false>((PG8_LAS unsigned char*)shm, g, S, E, nullptr); }
#pragma unroll 1
    for (int sl = 0; sl < 4; ++sl) {
        const int kofs = sl < 2 ? 768 * sl : 1536 + 640 * (sl - 2), ks = sl < 2 ? 768 : 640;
        pg8::Gemm g{(const bf16_t*)(ws + WS_ACT) + (size_t)NP * 2816 + kofs, (const bf16_t*)(ws + WS_WD) + kofs, 1024, 1024, ks, 2816, 2816}; pg8::StaticOrder S; S.init(g.M, g.N, G, (cB + G - (G / 4) * sl) % G);
        pg8::EpiPart E{(float*)(ws + WS_PART) + (size_t)sl * 1048576};
        pg8::gemm_phase<pg8::EpiPart, pg8::StaticOrder, false>((PG8_LAS unsigned char*)shm, g, S, E, nullptr); }
    xcd_barrier(xb); TSTAMP();
    phase_final(p);
#ifdef PROBE_A
    xcd_barrier(xb); TSTAMP();
    if (blockIdx.x == 0) { __syncthreads();
        const float dA = (float)(tsv[PROBE_A + 1] - tsv[PROBE_A]) * 0.01f, dB = (float)(tsv[PROBE_B + 1] - tsv[PROBE_B]) * 0.01f;
#ifdef EXP_BIGSCALE
        for (int i = threadIdx.x; i < 2048; i += NTHREADS) p.out[O_HP + i] += floorf(dA * 0.25f) * 4.0f * 0.1f;
#else
        for (int i = threadIdx.x; i < 2048; i += NTHREADS) p.out[O_HP + i] += dA * 0.01f;
#endif
        if (threadIdx.x == 0) p.out[O_Y] += dB * 0.1f; }
#endif
}

extern "C" void kernel_launch(void* const* d_in, const int* in_sizes, int n_in, void* d_out, int out_size, void* d_ws, size_t ws_size, hipStream_t stream) {
    static int grid_blocks = 0;
    if (!grid_blocks) {
        int dev = 0, cus = 0, per_cu = 0;
        (void)hipGetDevice(&dev); (void)hipDeviceGetAttribute(&cus, hipDeviceAttributeMultiprocessorCount, dev);
        (void)hipFuncSetAttribute((const void*)hymba_fwd, hipFuncAttributeMaxDynamicSharedMemorySize, LDS_BYTES);
        (void)hipOccupancyMaxActiveBlocksPerMultiprocessor(&per_cu, (const void*)hymba_fwd, NTHREADS, LDS_BYTES);
        if (per_cu < 1) { fprintf(stderr, "kernel_launch: occupancy query says %d blocks/CU\n", per_cu); per_cu = 1; }
        if (per_cu > 1) per_cu = 1;
        grid_blocks = cus * per_cu;
        (void)hipGetLastError();
    }
    (void)hipMemsetAsync((char*)d_ws + WS_BAR, 0, XCD_BAR_WORDS * 4, stream);
    Params p{};
    for (int i = 0; i < 26; ++i) p.in[i] = (const float*)d_in[i];
    p.out = (float*)d_out; p.ws = (unsigned char*)d_ws;
    void* args[] = {&p};
    hipError_t e = hipLaunchCooperativeKernel((const void*)hymba_fwd, dim3(grid_blocks), dim3(NTHREADS), args, LDS_BYTES, stream);
    if (e != hipSuccess) fprintf(stderr, "cooperative launch failed: %s (grid %d)\n", hipGetErrorString(e), grid_blocks);
}
```
